# Optimizing an MI355X kernel written in HIP

```python
import math, functools
import jax, jax.numpy as jnp
from jax import lax
import numpy as np

D_MODEL = 1024
BATCH = 2
SEQ = 8192
DEPTH = 2
DEC_BATCH = 128
DEC_SEQ = 8
PAST_LEN = 8192
PAGE_SIZE = 128

N_META = 16
CONV_WIDTH = 4
CHUNK = 64
BLOCK = 128
FRONT_PAD = BLOCK - N_META

DN_HEADS = 4
DN_DK = 128
DN_DV = 128
DN_QK = DN_HEADS * DN_DK
DN_V = DN_HEADS * DN_DV
DN_CONV = 2 * DN_QK + DN_V
SSM_HEADS = 4
SSM_HEADDIM = 64
SSM_GROUPS = 2
SSM_STATE = 128
SSM_INNER = SSM_HEADS * SSM_HEADDIM
SSM_BC = SSM_GROUPS * SSM_STATE
SSM_CONV = SSM_INNER + 2 * SSM_BC
SWA_Q_HEADS = 4
SWA_KV_HEADS = 2
SWA_HEAD_DIM = 64
SWA_Q = SWA_Q_HEADS * SWA_HEAD_DIM
SWA_KV = SWA_KV_HEADS * SWA_HEAD_DIM
WINDOW = 128
ROPE_THETA = 10000.0

D_MIX = DN_V + SSM_INNER + SWA_Q
D_FF = -(-8 * D_MODEL // (3 * 256)) * 256
IN_WIDTHS = (DN_CONV, DN_V, DN_HEADS, DN_HEADS, SSM_CONV, SSM_INNER, SSM_HEADS, SWA_Q, SWA_KV, SWA_KV)
D_IN = sum(IN_WIDTHS)

kernel_name = "hymba_style_deltanet_ssd_swa_decoder_step"


def rmsnorm(x, g, eps=1e-6):
    xf = x.astype(jnp.float32)
    y = xf * lax.rsqrt(jnp.mean(xf * xf, axis=-1, keepdims=True) + eps)
    return (y * g.astype(jnp.float32)).astype(x.dtype)


def l2norm(x, eps=1e-6):
    xf = x.astype(jnp.float32)
    return (xf * lax.rsqrt(jnp.sum(xf * xf, axis=-1, keepdims=True) + eps)).astype(x.dtype)


def split_cols(a, widths):
    return jnp.split(a, np.cumsum(widths)[:-1].tolist(), axis=-1)


def pad_front(a, n):
    return jnp.pad(a, [(0, 0), (n, 0)] + [(0, 0)] * (a.ndim - 2))


def causal_conv(u, buf, w):
    t = u.shape[1]
    full = jnp.concatenate([buf.astype(u.dtype), u], axis=1)
    out = full[:, 0:t] * w[0]
    for i in range(1, CONV_WIDTH):
        out = out + full[:, i:i + t] * w[i]
    return out, full[:, t:]


def rope(x, pos):
    half = x.shape[-1] // 2
    inv = ROPE_THETA ** (-jnp.arange(half, dtype=jnp.float32) / half)
    ang = pos.astype(jnp.float32)[:, None] * inv[None, :]
    cos = jnp.cos(ang)[None, :, None, :]
    sin = jnp.sin(ang)[None, :, None, :]
    xf = x.astype(jnp.float32)
    x1, x2 = xf[..., :half], xf[..., half:]
    return jnp.concatenate([x1 * cos - x2 * sin, x2 * cos + x1 * sin], axis=-1).astype(x.dtype)


def to_chunks(a, c):
    b, t = a.shape[:2]
    return jnp.swapaxes(a.reshape((b, t // c, c) + a.shape[2:]), 2, 3)


def from_chunks(a):
    a = jnp.swapaxes(a, 2, 3)
    return a.reshape((a.shape[0], a.shape[1] * a.shape[2]) + a.shape[3:])


def segment_decay(gc):
    c = gc.shape[-1]
    causal = jnp.tril(jnp.ones((c, c), bool))
    diff = gc[..., :, None] - gc[..., None, :]
    return jnp.where(causal, jnp.exp(jnp.where(causal, diff, 0.0)), 0.0)


def gated_delta_rule(q, k, v, g, beta, s0, chunk):
    f32 = jnp.float32
    dv = v.shape[-1]
    qc, kc, vc = (to_chunks(a.astype(f32), chunk) for a in (q, k, v))
    gc = jnp.cumsum(to_chunks(g.astype(f32), chunk), axis=-1)
    bc = to_chunks(beta.astype(f32), chunk)
    decay = segment_decay(gc)
    strict = jnp.tril(jnp.ones((chunk, chunk), bool), -1)
    a_mat = jnp.where(strict, bc[..., :, None] * jnp.einsum('bnhid,bnhjd->bnhij', kc, kc) * decay, 0.0)
    m = a_mat + jnp.eye(chunk, dtype=f32)
    rhs = jnp.concatenate([vc * bc[..., None], kc * (bc * jnp.exp(gc))[..., None]], axis=-1)
    sol = lax.linalg.triangular_solve(m, rhs, left_side=True, lower=True, unit_diagonal=True)
    u, w = sol[..., :dv], sol[..., dv:]
    attn = jnp.einsum('bnhid,bnhjd->bnhij', qc, kc) * decay
    q_dec = qc * jnp.exp(gc)[..., None]
    k_dec = kc * jnp.exp(gc[..., -1:] - gc)[..., None]
    g_last = jnp.exp(gc[..., -1])

    def step(s, inp):
        u_c, w_c, attn_c, qd_c, kd_c, gl_c = inp
        v_new = u_c - jnp.einsum('bhcd,bhde->bhce', w_c, s)
        o_c = jnp.einsum('bhcd,bhde->bhce', qd_c, s) + jnp.einsum('bhij,bhje->bhie', attn_c, v_new)
        s = s * gl_c[..., None, None] + jnp.einsum('bhcd,bhce->bhde', kd_c, v_new)
        return s, o_c

    xs = tuple(jnp.moveaxis(a, 1, 0) for a in (u, w, attn, q_dec, k_dec, g_last))
    s_final, o = lax.scan(step, s0.astype(f32), xs)
    return from_chunks(jnp.moveaxis(o, 0, 1)).astype(v.dtype), s_final


def ssd_scan(x, dt, a_neg, b_in, c_in, h0, chunk):
    f32 = jnp.float32
    rep = SSM_HEADS // SSM_GROUPS
    bc = to_chunks(jnp.repeat(b_in.astype(f32), rep, axis=2), chunk)
    cc = to_chunks(jnp.repeat(c_in.astype(f32), rep, axis=2), chunk)
    xdt = to_chunks(x.astype(f32) * dt.astype(f32)[..., None], chunk)
    gc = jnp.cumsum(to_chunks(dt.astype(f32) * a_neg.astype(f32), chunk), axis=-1)
    attn = jnp.einsum('bnhis,bnhjs->bnhij', cc, bc) * segment_decay(gc)
    y_intra = jnp.einsum('bnhij,bnhjp->bnhip', attn, xdt)
    c_dec = cc * jnp.exp(gc)[..., None]
    b_dec = bc * jnp.exp(gc[..., -1:] - gc)[..., None]
    g_last = jnp.exp(gc[..., -1])

    def step(h, inp):
        cd, bd, xd, gl = inp
        y_c = jnp.einsum('bhcs,bhps->bhcp', cd, h)
        h = h * gl[..., None, None] + jnp.einsum('bhcp,bhcs->bhps', xd, bd)
        return h, y_c

    xs = tuple(jnp.moveaxis(a, 1, 0) for a in (c_dec, b_dec, xdt, g_last))
    h_final, y_inter = lax.scan(step, h0.astype(f32), xs)
    y = y_intra + jnp.moveaxis(y_inter, 0, 1)
    return from_chunks(y).astype(x.dtype), h_final


def sink_softmax(scores, mask, sinks):
    s = jnp.where(mask, scores.astype(jnp.float32), -jnp.inf)
    sink = jnp.broadcast_to(sinks.astype(jnp.float32)[:, :, None, None], s.shape[:-1] + (1,))
    p = jax.nn.softmax(jnp.concatenate([s, sink], axis=-1), axis=-1)
    return p[..., :-1]


def swa_prompt(q, k, v, sinks):
    b, L = q.shape[:2]
    grp = SWA_Q_HEADS // SWA_KV_HEADS
    lp = L + FRONT_PAD
    nb = lp // BLOCK
    qb = pad_front(q, FRONT_PAD).reshape(b, nb, BLOCK, SWA_KV_HEADS, grp, SWA_HEAD_DIM)

    def band(a):
        ap = pad_front(a, FRONT_PAD + BLOCK).reshape(b, nb + 1, BLOCK, SWA_KV_HEADS, SWA_HEAD_DIM)
        return jnp.concatenate([ap[:, :-1], ap[:, 1:]], axis=2)

    kb, vb = band(k), band(v)
    scores = jnp.einsum('bnqkgd,bnskd->bnkgqs', qb, kb) * SWA_HEAD_DIM ** -0.5
    qi = jnp.arange(BLOCK)[:, None] + BLOCK
    kj = jnp.arange(2 * BLOCK)[None, :]
    rel = qi - kj
    kpos = (jnp.arange(nb)[:, None, None] - 1) * BLOCK + kj[None]
    mask = (rel >= 0) & (rel < WINDOW) & (kpos >= FRONT_PAD)
    p = sink_softmax(scores, mask[None, :, None, None], sinks.reshape(SWA_KV_HEADS, grp))
    o = jnp.einsum('bnkgqs,bnskd->bnqkgd', p.astype(vb.dtype), vb)
    o = o.reshape(b, lp, SWA_Q_HEADS, SWA_HEAD_DIM)[:, FRONT_PAD:]
    return o, k[:, -WINDOW:], v[:, -WINDOW:]


def swa_sample(q, k, v, sinks, k_buf, v_buf):
    t = q.shape[1]
    grp = SWA_Q_HEADS // SWA_KV_HEADS
    keys = jnp.concatenate([k_buf.astype(k.dtype), k], axis=1)
    vals = jnp.concatenate([v_buf.astype(v.dtype), v], axis=1)
    qg = q.reshape(q.shape[0], t, SWA_KV_HEADS, grp, SWA_HEAD_DIM)
    scores = jnp.einsum('btkgd,bskd->bkgts', qg, keys) * SWA_HEAD_DIM ** -0.5
    rel = (WINDOW + jnp.arange(t))[:, None] - jnp.arange(WINDOW + t)[None, :]
    mask = (rel >= 0) & (rel < WINDOW)
    p = sink_softmax(scores, mask, sinks.reshape(SWA_KV_HEADS, grp))
    o = jnp.einsum('bkgts,bskd->btkgd', p.astype(vals.dtype), vals).reshape(q.shape)
    return o, keys[:, -WINDOW:], vals[:, -WINDOW:]


def hybrid_mixer(h, pos, lw, states, front_pad, chunk, attend):
    dn_s0, dn_buf, ssm_s0, ssm_buf = states
    f32 = jnp.float32
    bsz, t = h.shape[:2]
    (dn_qkv, dn_z, dn_b, dn_a, ssm_xbc, ssm_z, ssm_dt, sw_q, sw_k, sw_v) = split_cols(h @ lw['w_in'], IN_WIDTHS)
    qkv, dn_buf_new = causal_conv(dn_qkv, dn_buf, lw['dn_conv_w'])
    q, k, v = split_cols(jax.nn.silu(qkv), (DN_QK, DN_QK, DN_V))
    q = l2norm(q.reshape(bsz, t, DN_HEADS, DN_DK)) * DN_DK ** -0.5
    k = l2norm(k.reshape(bsz, t, DN_HEADS, DN_DK))
    v = v.reshape(bsz, t, DN_HEADS, DN_DV)
    beta = jax.nn.sigmoid(dn_b.astype(f32))
    g = -jnp.exp(lw['dn_a_log'].astype(f32)) * jax.nn.softplus(dn_a.astype(f32) + lw['dn_dt_bias'].astype(f32))
    o_dn, dn_s = gated_delta_rule(*(pad_front(a, front_pad) for a in (q, k, v, g, beta)), dn_s0, chunk)
    o_dn = rmsnorm(o_dn[:, front_pad:], lw['dn_norm_w']) * jax.nn.silu(dn_z.reshape(bsz, t, DN_HEADS, DN_DV))
    xbc, ssm_buf_new = causal_conv(ssm_xbc, ssm_buf, lw['ssm_conv_w'])
    xs, bs, cs = split_cols(jax.nn.silu(xbc + lw['ssm_conv_b']), (SSM_INNER, SSM_BC, SSM_BC))
    xs = xs.reshape(bsz, t, SSM_HEADS, SSM_HEADDIM)
    bs = bs.reshape(bsz, t, SSM_GROUPS, SSM_STATE)
    cs = cs.reshape(bsz, t, SSM_GROUPS, SSM_STATE)
    dt = jax.nn.softplus(ssm_dt.astype(f32) + lw['ssm_dt_bias'].astype(f32))
    a_neg = -jnp.exp(lw['ssm_a_log'].astype(f32))
    y, ssm_s = ssd_scan(pad_front(xs, front_pad), pad_front(dt, front_pad), a_neg,
                        pad_front(bs, front_pad), pad_front(cs, front_pad), ssm_s0, chunk)
    y = (y[:, front_pad:] + xs * lw['ssm_d'][:, None]) * jax.nn.silu(ssm_z.reshape(bsz, t, SSM_HEADS, SSM_HEADDIM))
    y = rmsnorm(y.reshape(bsz, t, SSM_GROUPS, SSM_INNER // SSM_GROUPS),
                lw['ssm_norm_w'].reshape(SSM_GROUPS, SSM_INNER // SSM_GROUPS))
    qa = rope(sw_q.reshape(bsz, t, SWA_Q_HEADS, SWA_HEAD_DIM), pos)
    ka = rope(sw_k.reshape(bsz, t, SWA_KV_HEADS, SWA_HEAD_DIM), pos)
    va = sw_v.reshape(bsz, t, SWA_KV_HEADS, SWA_HEAD_DIM)
    o_sw, k_new, v_new = attend(qa, ka, va, lw['swa_sinks'])
    mixed = jnp.concatenate([o_dn.reshape(bsz, t, DN_V), y.reshape(bsz, t, SSM_INNER),
                             o_sw.reshape(bsz, t, SWA_Q)], axis=-1)
    return mixed @ lw['w_out'], (dn_s, dn_buf_new, ssm_s, ssm_buf_new, k_new, v_new)


def trunk_layer(x, pos, lw, states, front_pad, chunk, attend):
    m, new_states = hybrid_mixer(rmsnorm(x, lw['g_pre_mix']), pos, lw, states, front_pad, chunk, attend)
    x = x + rmsnorm(m, lw['g_post_mix'])
    gate, up = jnp.split(rmsnorm(x, lw['g_pre_ffn']) @ lw['w_ffn_in'], 2, axis=-1)
    x = x + rmsnorm((jax.nn.silu(gate) * up) @ lw['w_ffn_out'], lw['g_post_ffn'])
    return x, new_states


def setup_inputs(seed: int = 0) -> dict:
    key = jax.random.key(seed)
    ks = jax.random.split(key, 32)
    f32 = jnp.float32

    def normal(kk, shape, scale):
        return jax.random.normal(kk, shape, f32) * scale

    def gain(kk, shape):
        return 1.0 + normal(kk, shape, 0.02)

    def dt_bias(kk, shape):
        dt = jnp.exp(jax.random.uniform(kk, shape, f32, math.log(1e-3), math.log(1e-1)))
        return dt + jnp.log(-jnp.expm1(-dt))

    def a_log(kk, shape):
        return jnp.log(jax.random.uniform(kk, shape, f32, 1.0, 16.0))

    return {
        "x_prompt": normal(ks[0], (BATCH, SEQ, D_MODEL), 1.0),
        "x_sample": normal(ks[1], (DEC_BATCH, DEC_SEQ, D_MODEL), 1.0),
        "state_dn": normal(ks[2], (DEPTH, DEC_BATCH, DN_HEADS, DN_DK, DN_DV), 0.1),
        "state_dn_conv": normal(ks[3], (DEPTH, DEC_BATCH, CONV_WIDTH - 1, DN_CONV), 1.0),
        "state_ssm": normal(ks[4], (DEPTH, DEC_BATCH, SSM_HEADS, SSM_HEADDIM, SSM_STATE), 0.1),
        "state_ssm_conv": normal(ks[5], (DEPTH, DEC_BATCH, CONV_WIDTH - 1, SSM_CONV), 1.0),
        "cache_swa_k": normal(ks[6], (DEPTH, DEC_BATCH, WINDOW, SWA_KV_HEADS, SWA_HEAD_DIM), 1.0),
        "cache_swa_v": normal(ks[7], (DEPTH, DEC_BATCH, WINDOW, SWA_KV_HEADS, SWA_HEAD_DIM), 1.0),
        "meta_tokens": normal(ks[8], (N_META, D_MODEL), 1.0),
        "w_in": normal(ks[9], (DEPTH, D_MODEL, D_IN), D_MODEL ** -0.5),
        "dn_conv_w": normal(ks[10], (DEPTH, CONV_WIDTH, DN_CONV), CONV_WIDTH ** -0.5),
        "dn_a_log": a_log(ks[11], (DEPTH, DN_HEADS)),
        "dn_dt_bias": dt_bias(ks[12], (DEPTH, DN_HEADS)),
        "dn_norm_w": gain(ks[13], (DEPTH, DN_DV)),
        "ssm_conv_w": normal(ks[14], (DEPTH, CONV_WIDTH, SSM_CONV), CONV_WIDTH ** -0.5),
        "ssm_conv_b": normal(ks[15], (DEPTH, SSM_CONV), 0.02),
        "ssm_a_log": a_log(ks[16], (DEPTH, SSM_HEADS)),
        "ssm_dt_bias": dt_bias(ks[17], (DEPTH, SSM_HEADS)),
        "ssm_d": 1.0 + normal(ks[18], (DEPTH, SSM_HEADS), 0.1),
        "ssm_norm_w": gain(ks[19], (DEPTH, SSM_INNER)),
        "swa_sinks": normal(ks[20], (DEPTH, SWA_Q_HEADS), 0.5),
        "w_out": normal(ks[21], (DEPTH, D_MIX, D_MODEL), D_MIX ** -0.5),
        "g_pre_mix": gain(ks[22], (DEPTH, D_MODEL)),
        "g_post_mix": gain(ks[23], (DEPTH, D_MODEL)),
        "g_pre_ffn": gain(ks[24], (DEPTH, D_MODEL)),
        "g_post_ffn": gain(ks[25], (DEPTH, D_MODEL)),
        "w_ffn_in": normal(ks[26], (DEPTH, D_MODEL, 2 * D_FF), D_MODEL ** -0.5),
        "w_ffn_out": normal(ks[27], (DEPTH, D_FF, D_MODEL), D_FF ** -0.5),
    }


def reference(x_prompt, x_sample, state_dn, state_dn_conv, state_ssm, state_ssm_conv, cache_swa_k, cache_swa_v,
              meta_tokens, w_in, dn_conv_w, dn_a_log, dn_dt_bias, dn_norm_w, ssm_conv_w, ssm_conv_b, ssm_a_log,
              ssm_dt_bias, ssm_d, ssm_norm_w, swa_sinks, w_out, g_pre_mix, g_post_mix, g_pre_ffn, g_post_ffn,
              w_ffn_in, w_ffn_out):
    bp = x_prompt.shape[0]
    meta = jnp.broadcast_to(meta_tokens[None].astype(x_prompt.dtype), (bp, N_META, D_MODEL))
    xp = jnp.concatenate([meta, x_prompt], axis=1)
    xs = x_sample
    pos_p = jnp.arange(xp.shape[1], dtype=jnp.int32)
    pos_s = PAST_LEN + jnp.arange(xs.shape[1], dtype=jnp.int32)
    zero_states = (jnp.zeros((bp, DN_HEADS, DN_DK, DN_DV), jnp.float32),
                   jnp.zeros((bp, CONV_WIDTH - 1, DN_CONV), xp.dtype),
                   jnp.zeros((bp, SSM_HEADS, SSM_HEADDIM, SSM_STATE), jnp.float32),
                   jnp.zeros((bp, CONV_WIDTH - 1, SSM_CONV), xp.dtype))
    new_p, new_s = [], []
    for l in range(DEPTH):
        lw = dict(w_in=w_in[l], dn_conv_w=dn_conv_w[l], dn_a_log=dn_a_log[l], dn_dt_bias=dn_dt_bias[l],
                  dn_norm_w=dn_norm_w[l], ssm_conv_w=ssm_conv_w[l], ssm_conv_b=ssm_conv_b[l],
                  ssm_a_log=ssm_a_log[l], ssm_dt_bias=ssm_dt_bias[l], ssm_d=ssm_d[l], ssm_norm_w=ssm_norm_w[l],
                  swa_sinks=swa_sinks[l], w_out=w_out[l], g_pre_mix=g_pre_mix[l], g_post_mix=g_post_mix[l],
                  g_pre_ffn=g_pre_ffn[l], g_post_ffn=g_post_ffn[l], w_ffn_in=w_ffn_in[l], w_ffn_out=w_ffn_out[l])
        xp, st_p = trunk_layer(xp, pos_p, lw, zero_states, FRONT_PAD, CHUNK, swa_prompt)
        xs, st_s = trunk_layer(xs, pos_s, lw, (state_dn[l], state_dn_conv[l], state_ssm[l], state_ssm_conv[l]),
                               0, xs.shape[1],
                               functools.partial(swa_sample, k_buf=cache_swa_k[l], v_buf=cache_swa_v[l]))
        new_p.append(st_p)
        new_s.append(st_s)
    dn_p, dnc_p, ssm_p, ssmc_p, k_p, v_p = (jnp.stack([st[i] for st in new_p]) for i in range(6))
    dn_s, dnc_s, ssm_s, ssmc_s, k_s, v_s = (jnp.stack([st[i] for st in new_s]) for i in range(6))
    return (xp[:, N_META:], xs, dn_p, dnc_p, ssm_p, ssmc_p, k_p, v_p, dn_s, dnc_s, ssm_s, ssmc_s, k_s, v_s)
```

```cpp
#include <hip/hip_runtime.h>
#include <cstdio>
#include <cstdint>

namespace pg8 {
#define PG8_LAS __attribute__((address_space(3)))
typedef unsigned short bf16_t;
typedef short bf16x8 __attribute__((ext_vector_type(8)));
typedef float f32x4 __attribute__((ext_vector_type(4)));
typedef unsigned u32x4 __attribute__((ext_vector_type(4)));
constexpr int BM = 256, BK = 64, HALF = 128, HTB = HALF * BK * 2  , STAGE_BYTES = 8 * HTB, NXCD = 8, WGM = 8;

__host__ __device__ __forceinline__ int lds_byte(int r, int c) { const int st = (r >> 4) * 2 + (c >> 5), rr = r & 15, cc = c & 31, ob = rr * 64 + cc * 2; return st * 1024 + (ob ^ (((ob >> 9) & 1) << 5)); }
__host__ __device__ __forceinline__ void stage_rc(int b, int& R, int& C) { const int st = b / 1024, sb = b % 1024, swz = sb ^ (((sb >> 9) & 1) << 5); R = (st >> 1) * 16 + swz / 64; C = (st & 1) * 32 + (swz % 64) / 2; }
__host__ __device__ __forceinline__ int perm32(int rho) { const int n = rho >> 4, i = rho & 15; return 8 * (i >> 2) + 4 * n + (i & 3); }

struct Unit { int pm, pn; };
struct Gemm { const bf16_t* A; const bf16_t* Bt; int M, N, K; };

struct StaticOrder {
    int nM, nN, nwg, G, c;
    __host__ __device__ void init(int M, int N, int G_, int c_) { nM = M / BM; nN = N / BM; nwg = nM * nN; G = G_; c = c_; }
    __host__ __device__ bool next(int i, Unit& u) const {
        const long L = (long)i * G + c; if (L >= nwg) return false;
        int wgid = (int)L; { const int q = nwg / NXCD, r = nwg % NXCD, xcd = wgid % NXCD, off = wgid / NXCD; wgid = (xcd < r ? xcd * (q + 1) : r * (q + 1) + (xcd - r) * q) + off; }
        const int nig = WGM * nN, gid = wgid / nig, fm = gid * WGM, gsz = (nM - fm) < WGM ? (nM - fm) : WGM;
        u.pm = fm + ((wgid % nig) % gsz); u.pn = (wgid % nig) / gsz; return true;
    }
    __device__ __forceinline__ void a_ready(const Unit&) const {}
    __device__ __forceinline__ void done(const Unit&) const {}
};

__device__ __forceinline__ unsigned cvt_pk_bf16(float lo, float hi) { unsigned r; asm volatile("v_cvt_pk_bf16_f32 %0, %1, %2" : "=v"(r) : "v"(lo), "v"(hi)); return r; }
typedef float f32x2 __attribute__((ext_vector_type(2)));
__device__ __forceinline__ f32x2 gelu_pk(f32x2 v) {
    const f32x2 av = __builtin_elementwise_abs(v), d = av * 0.2316418882f + 1.0f;
    f32x2 t; t.x = __builtin_amdgcn_rcpf(d.x); t.y = __builtin_amdgcn_rcpf(d.y);
    f32x2 q = t * 0.5307027145f + (-0.7265760135f); q = q * t + 0.7107068705f; q = q * t + (-0.142248368f); q = q * t + 0.127414796f; q = q * t;
    const f32x2 s = (v * v) * (-0.72134752044f);
    f32x2 e; e.x = __builtin_amdgcn_exp2f(s.x); e.y = __builtin_amdgcn_exp2f(s.y);
    const f32x2 m = v * (q * e), r = v - m;
    f32x2 o; o.x = v.x < 0.f ? m.x : r.x; o.y = v.y < 0.f ? m.y : r.y; return o;
}

template <int ACT  > struct EpiBf16 {
    static constexpr bool PERM = true, AFTER_DRAIN = false; static_assert(ACT == 0 || ACT == 1, "EpiBf16: ACT is 0 (none) or 1 (gelu_pk)");
    bf16_t* O; int ldc; const float* bias; int split_cols; size_t split_stride; float scale0;
    __device__ __forceinline__ void operator()(const f32x4 (&acc)[2][2][4][2], const Unit& u, int wr, int wc, int fr, int fq) const {
        const int row0 = u.pm * BM + wr * 64 + fr; int colt = u.pn * BM; bf16_t* base = O;
        float sc = 1.f; if (split_cols) { const int t = colt / split_cols; base += (size_t)t * split_stride; colt -= t * split_cols; if (t == 0) sc = scale0; }
        const int col0 = colt + wc * 32 + 8 * fq, bcol0 = u.pn * BM + wc * 32 + 8 * fq;
        f32x4 bv[2][2];
#pragma unroll
        for (int bj = 0; bj < 2; ++bj)
#pragma unroll
            for (int n = 0; n < 2; ++n) bv[bj][n] = bias ? *(const f32x4*)(bias + bcol0 + bj * HALF + 4 * n) : (f32x4){0.f, 0.f, 0.f, 0.f};
#pragma unroll
        for (int ai = 0; ai < 2; ++ai)
#pragma unroll
            for (int m = 0; m < 4; ++m) { bf16_t* rowp = base + (size_t)(row0 + ai * HALF + m * 16) * ldc + col0;
#pragma unroll
                for (int bj = 0; bj < 2; ++bj) { f32x4 v0 = acc[ai][bj][m][0] + bv[bj][0], v1 = acc[ai][bj][m][1] + bv[bj][1];
                    if (ACT == 1) { f32x2 a = gelu_pk((f32x2){v0[0], v0[1]}), b = gelu_pk((f32x2){v0[2], v0[3]}), c = gelu_pk((f32x2){v1[0], v1[1]}), d = gelu_pk((f32x2){v1[2], v1[3]});
                        v0 = (f32x4){a.x, a.y, b.x, b.y}; v1 = (f32x4){c.x, c.y, d.x, d.y}; }
                    v0 = v0 * sc; v1 = v1 * sc; u32x4 w; w.x = cvt_pk_bf16(v0[0], v0[1]); w.y = cvt_pk_bf16(v0[2], v0[3]); w.z = cvt_pk_bf16(v1[0], v1[1]); w.w = cvt_pk_bf16(v1[2], v1[3]);
                    *(u32x4*)(rowp + bj * HALF) = w; } }
    }
};

struct EpiSwiGLU {
    static constexpr bool PERM = true, AFTER_DRAIN = false;
    bf16_t* O; int ldc;
    __device__ __forceinline__ void operator()(const f32x4 (&acc)[2][2][4][2], const Unit& u, int wr, int wc, int fr, int fq) const {
        const int row0 = u.pm * BM + wr * 64 + fr; const int col0 = u.pn * HALF + wc * 32 + 8 * fq;
#pragma unroll
        for (int ai = 0; ai < 2; ++ai)
#pragma unroll
            for (int m = 0; m < 4; ++m) { bf16_t* rowp = O + (size_t)(row0 + ai * HALF + m * 16) * ldc + col0;
                float v[8];
#pragma unroll
                for (int n = 0; n < 2; ++n)
#pragma unroll
                    for (int e = 0; e < 4; ++e) { const float g = acc[ai][0][m][n][e], up = acc[ai][1][m][n][e]; v[n * 4 + e] = g * __builtin_amdgcn_rcpf(1.f + __expf(-g)) * up; }
                u32x4 w; w.x = cvt_pk_bf16(v[0], v[1]); w.y = cvt_pk_bf16(v[2], v[3]); w.z = cvt_pk_bf16(v[4], v[5]); w.w = cvt_pk_bf16(v[6], v[7]);
                *(u32x4*)rowp = w; }
    }
};

template <class Epi, class Sched, bool ALIGN_EPI = false, bool SP2 = false>
__device__ __forceinline__ void gemm_phase(PG8_LAS unsigned char* lds, const Gemm g, const Sched& S, const Epi& E, const int tid_in) {
    const int tid = tid_in, wid = __builtin_amdgcn_readfirstlane(tid >> 6), lane = tid & 63, wr = wid >> 2, wc = wid & 3, fr = lane & 15, fq = lane >> 4;
    const int K = g.K, nt = K / BK;
    unsigned voffA[2], voffB[2];
#pragma unroll
    for (int i = 0; i < 2; ++i) { int R, C; stage_rc(tid * 16 + i * 8192, R, C); const int Rb = Epi::PERM ? ((R & ~31) + perm32(R & 31)) : R;
        voffA[i] = (unsigned)(R * K + C) * 2u; voffB[i] = (unsigned)(Rb * K + C) * 2u; }
    const size_t kstep = (size_t)(BK * 2);
    const size_t hstep = (size_t)HALF * K * 2;
    const size_t tstep = 2 * hstep;
    const unsigned ldsw = (unsigned)wid * 1024u;
    const int aoff = lds_byte(wr * 64 + fr, fq * 8), boff = lds_byte(wc * 32 + fr, fq * 8);
#define PG8_SA(b, h) (((b) * 2 + (h)) * HTB)
#define PG8_SB(b, h) ((4 + (b) * 2 + (h)) * HTB)
#define PG8_STAGE(bufoff, gbase, voff) do { _Pragma("unroll") for (int _i = 0; _i < 2; ++_i) \
        __builtin_amdgcn_global_load_lds((const unsigned*)((const char*)(gbase) + (voff)[_i]), (PG8_LAS unsigned*)(lds + (bufoff) + ldsw + _i * 8192), 16, 0, 0); } while (0)
#define PG8_LDA(dst, b, h) do { _Pragma("unroll") for (int m = 0; m < 4; ++m) _Pragma("unroll") for (int k = 0; k < 2; ++k) dst[m][k] = *(const PG8_LAS bf16x8*)(lds + PG8_SA(b, h) + aoff + m * 2048 + k * 1024); } while (0)
#define PG8_LDB(dst, b, h) do { _Pragma("unroll") for (int n = 0; n < 2; ++n) _Pragma("unroll") for (int k = 0; k < 2; ++k) dst[n][k] = *(const PG8_LAS bf16x8*)(lds + PG8_SB(b, h) + boff + n * 2048 + k * 1024); } while (0)
#define PG8_MMA(ai, bj, At, Bt) do { __builtin_amdgcn_s_setprio(1); _Pragma("unroll") for (int m = 0; m < 4; ++m) _Pragma("unroll") for (int n = 0; n < 2; ++n) _Pragma("unroll") for (int k = 0; k < 2; ++k) \
        acc[ai][bj][m][n] = __builtin_amdgcn_mfma_f32_16x16x32_bf16(Bt[n][k], At[m][k], acc[ai][bj][m][n], 0, 0, 0); __builtin_amdgcn_s_setprio(0); } while (0)
#define PG8_WAIT_V(n) asm volatile("s_waitcnt vmcnt(" #n ")" ::: "memory")
#define PG8_WAIT_L(n) asm volatile("s_waitcnt lgkmcnt(" #n ")" ::: "memory")
#define PG8_BAR __builtin_amdgcn_s_barrier()
#define PG8_SCHED __builtin_amdgcn_sched_barrier(0)
    Unit cur, nxt; int ui = 0;
    if (!S.next(0, cur)) return;
    f32x4 acc[2][2][4][2];
#pragma unroll
    for (int a = 0; a < 2; ++a)
#pragma unroll
        for (int b = 0; b < 2; ++b)
#pragma unroll
            for (int m = 0; m < 4; ++m)
#pragma unroll
                for (int n = 0; n < 2; ++n) acc[a][b][m][n] = (f32x4){0.f, 0.f, 0.f, 0.f};
    bf16x8 At[4][2], B0[2][2], B1[2][2];
    const char* cA = (const char*)g.A + (size_t)cur.pm * tstep; const char* cB = (const char*)g.Bt + (size_t)cur.pn * tstep;
    S.a_ready(cur);
    if constexpr (SP2) {
        PG8_STAGE(PG8_SB(0, 0), cB, voffB); PG8_STAGE(PG8_SB(0, 1), cB + hstep, voffB); PG8_STAGE(PG8_SA(0, 0), cA, voffA); PG8_STAGE(PG8_SA(0, 1), cA + hstep, voffA);
        if (wr == 1) PG8_BAR;
        PG8_WAIT_V(2); PG8_BAR;
        PG8_STAGE(PG8_SB(1, 0), cB + kstep, voffB); PG8_STAGE(PG8_SA(1, 0), cA + kstep, voffA); PG8_STAGE(PG8_SB(1, 1), cB + hstep + kstep, voffB);
        PG8_WAIT_V(6); PG8_BAR;
    } else {
        PG8_STAGE(PG8_SB(0, 0), cB, voffB); PG8_STAGE(PG8_SA(0, 0), cA, voffA); PG8_STAGE(PG8_SB(0, 1), cB + hstep, voffB); PG8_STAGE(PG8_SA(0, 1), cA + hstep, voffA);
        if (wr == 1) PG8_BAR;
        PG8_WAIT_V(4); PG8_BAR;
        PG8_STAGE(PG8_SB(1, 0), cB + kstep, voffB); PG8_STAGE(PG8_SA(1, 0), cA + kstep, voffA); PG8_STAGE(PG8_SB(1, 1), cB + hstep + kstep, voffB);
        PG8_WAIT_V(6); PG8_BAR;
    }
    for (;;) {
        const bool has_next = S.next(ui + 1, nxt);
        const char* nA = has_next ? (const char*)g.A + (size_t)nxt.pm * tstep : cA; const char* nB = has_next ? (const char*)g.Bt + (size_t)nxt.pn * tstep : cB;
        for (int t = 0; t < nt; t += 2) {
            const bool last = (t == nt - 2);
            const char* a1 = cA + (size_t)(t + 1) * kstep;
            const char* a2 = last ? nA : cA + (size_t)(t + 2) * kstep; const char* b2 = last ? nB : cB + (size_t)(t + 2) * kstep;
            const char* a3 = a2 + kstep; const char* b3 = b2 + kstep;
            if (last && has_next) S.a_ready(nxt);
            if constexpr (SP2) {
            PG8_LDB(B0, 0, 0); PG8_LDB(B1, 0, 1); PG8_SCHED; PG8_LDA(At, 0, 0); PG8_STAGE(PG8_SA(1, 1), a1 + hstep, voffA);
            PG8_WAIT_V(8); PG8_WAIT_L(0); PG8_BAR; PG8_MMA(0, 0, At, B0); PG8_MMA(0, 1, At, B1); PG8_BAR; PG8_SCHED;
            PG8_LDA(At, 0, 1); PG8_STAGE(PG8_SB(0, 0), b2, voffB); PG8_STAGE(PG8_SB(0, 1), b2 + hstep, voffB); PG8_STAGE(PG8_SA(0, 0), a2, voffA);
            PG8_WAIT_V(8); PG8_WAIT_L(0); PG8_BAR; PG8_MMA(1, 0, At, B0); PG8_MMA(1, 1, At, B1); PG8_BAR; PG8_SCHED;
            PG8_LDB(B0, 1, 0); PG8_LDB(B1, 1, 1); PG8_SCHED; PG8_LDA(At, 1, 0); PG8_STAGE(PG8_SA(0, 1), a2 + hstep, voffA);
            PG8_WAIT_V(8); PG8_WAIT_L(0); PG8_BAR; PG8_MMA(0, 0, At, B0); PG8_MMA(0, 1, At, B1); PG8_BAR; PG8_SCHED;
            PG8_LDA(At, 1, 1); PG8_STAGE(PG8_SB(1, 0), b3, voffB); PG8_STAGE(PG8_SB(1, 1), b3 + hstep, voffB); PG8_STAGE(PG8_SA(1, 0), a3, voffA);
            PG8_WAIT_V(8); PG8_WAIT_L(0); PG8_BAR; PG8_MMA(1, 0, At, B0); PG8_MMA(1, 1, At, B1); PG8_BAR; PG8_SCHED;
            } else {
            PG8_LDB(B0, 0, 0); PG8_SCHED; PG8_LDA(At, 0, 0); PG8_STAGE(PG8_SA(1, 1), a1 + hstep, voffA);
            PG8_WAIT_L(8); PG8_BAR; PG8_WAIT_L(0); PG8_MMA(0, 0, At, B0); PG8_BAR; PG8_SCHED;
            PG8_LDB(B1, 0, 1); PG8_STAGE(PG8_SB(0, 0), b2, voffB);
            PG8_BAR; PG8_WAIT_L(0); PG8_MMA(0, 1, At, B1); PG8_BAR;
            PG8_LDA(At, 0, 1); PG8_STAGE(PG8_SA(0, 0), a2, voffA);
            PG8_BAR; PG8_WAIT_L(0); PG8_MMA(1, 0, At, B0); PG8_BAR; PG8_SCHED;
            PG8_STAGE(PG8_SB(0, 1), b2 + hstep, voffB);
            PG8_WAIT_V(6); PG8_BAR; PG8_MMA(1, 1, At, B1); PG8_BAR;
            PG8_LDB(B0, 1, 0); PG8_SCHED; PG8_LDA(At, 1, 0); PG8_STAGE(PG8_SA(0, 1), a2 + hstep, voffA);
            PG8_WAIT_L(8); PG8_BAR; PG8_WAIT_L(0); PG8_MMA(0, 0, At, B0); PG8_BAR; PG8_SCHED;
            PG8_LDB(B1, 1, 1); PG8_STAGE(PG8_SB(1, 0), b3, voffB);
            PG8_BAR; PG8_WAIT_L(0); PG8_MMA(0, 1, At, B1); PG8_BAR;
            PG8_LDA(At, 1, 1); PG8_STAGE(PG8_SA(1, 0), a3, voffA);
            PG8_BAR; PG8_WAIT_L(0); PG8_MMA(1, 0, At, B0); PG8_BAR; PG8_SCHED;
            PG8_STAGE(PG8_SB(1, 1), b3 + hstep, voffB);
            PG8_WAIT_V(6); PG8_BAR; PG8_MMA(1, 1, At, B1); PG8_BAR;
            }
        }
        if constexpr (ALIGN_EPI) { if (wr == 0) PG8_BAR; }
        if constexpr (!Epi::AFTER_DRAIN) { E(acc, cur, wr, wc, fr, fq); S.done(cur); }
        if (!has_next) break;
#pragma unroll
        for (int a = 0; a < 2; ++a)
#pragma unroll
            for (int b = 0; b < 2; ++b)
#pragma unroll
                for (int m = 0; m < 4; ++m)
#pragma unroll
                    for (int n = 0; n < 2; ++n) acc[a][b][m][n] = (f32x4){0.f, 0.f, 0.f, 0.f};
        cur = nxt; cA = nA; cB = nB; ++ui;
        if constexpr (ALIGN_EPI) { if (wr == 1) PG8_BAR; }
    }
    PG8_WAIT_V(0);
    if constexpr (!ALIGN_EPI) { if (wr == 0) PG8_BAR; }
    PG8_BAR;
    if constexpr (Epi::AFTER_DRAIN) { E.fused(acc, cur, wr, wc, fr, fq, lds, wid, lane); S.done(cur); }
#undef PG8_SA
#undef PG8_SB
#undef PG8_STAGE
#undef PG8_LDA
#undef PG8_LDB
#undef PG8_MMA
#undef PG8_WAIT_V
#undef PG8_WAIT_L
#undef PG8_BAR
#undef PG8_SCHED
}
}

#define GAS __attribute__((address_space(1)))
#define LAS __attribute__((address_space(3)))
typedef unsigned short bf16;
typedef unsigned v4u __attribute__((ext_vector_type(4)));
typedef float f32x4 __attribute__((ext_vector_type(4)));
typedef short bf16x8 __attribute__((ext_vector_type(8)));
typedef GAS unsigned gu32;
typedef GAS unsigned long long gu64;
#define RLX_AGENT __ATOMIC_RELAXED, __HIP_MEMORY_SCOPE_AGENT
#define LDS_WAIT() asm volatile("s_waitcnt lgkmcnt(0)" ::: "memory")
#define VM_WAIT() asm volatile("s_waitcnt vmcnt(0)" ::: "memory")
__device__ __forceinline__ unsigned long long rt() { return __builtin_amdgcn_s_memrealtime(); }
__device__ __forceinline__ unsigned f2bf(float f) { unsigned u = __builtin_bit_cast(unsigned, f); return (u + 0x7fffu + ((u >> 16) & 1u)) >> 16; }
__device__ __forceinline__ unsigned pk2(float lo, float hi) { return f2bf(lo) | (f2bf(hi) << 16); }

#define XB_TMO      128
#define XB_XCNT(j)  (256  + 64 * (j))
#define XB_XSUB(j)  (1280 + 64 * (j))
#define XB_XGEN(j)  (2304 + 64 * (j))
#define XB_TOP      3328
#define XB_TOPGEN   3392
#define XCD_BAR_WORDS 3456
#define XB_SPIN_CAP (1u << 18)

__device__ __forceinline__ unsigned xb_ld(unsigned* p)              { return __hip_atomic_load(p, __ATOMIC_RELAXED, __HIP_MEMORY_SCOPE_AGENT); }
__device__ __forceinline__ unsigned xb_add(unsigned* p, unsigned v) { return __hip_atomic_fetch_add(p, v, __ATOMIC_RELAXED, __HIP_MEMORY_SCOPE_AGENT); }
__device__ __forceinline__ unsigned xb_xcc_id() { return (unsigned)__builtin_amdgcn_s_getreg((3 << 11) | 20) & 0xFu; }
#define XB_SPIN(cond, bar) do { unsigned _sp = 0; while (cond) { __builtin_amdgcn_s_sleep(1); \
    if ((++_sp & 255u) == 0u) { if (xb_ld(&(bar)[XB_TMO])) break; if (_sp > XB_SPIN_CAP) { atomicAdd(&(bar)[XB_TMO], 1u); break; } } } } while (0)

struct XcdBarrier {
    unsigned* bar; unsigned x;
    volatile LAS unsigned* st;
};

__device__ __forceinline__ XcdBarrier xcd_barrier_post(unsigned* bar, volatile LAS unsigned* st, const int tid) {
    XcdBarrier b; b.bar = bar; b.x = xb_xcc_id(); b.st = st;
    if (tid == 0) (void)xb_add(&bar[XB_XCNT(b.x)], 1u);
    return b;
}
__device__ __forceinline__ void xcd_barrier_complete(unsigned* bar, unsigned x, unsigned& nloc, unsigned& nx) {
    const unsigned G = gridDim.x * gridDim.y * gridDim.z;
    unsigned sum, cnt, mine, sp = 0u;
    for (;;) {
        sum = 0u; cnt = 0u; mine = 0u;
#pragma unroll
        for (unsigned j = 0; j < 16; ++j) { const unsigned c = xb_ld(&bar[XB_XCNT(j)]); sum += c; cnt += (c > 0u) ? 1u : 0u; mine = (j == x) ? c : mine; }
        if (sum == G) break;
        __builtin_amdgcn_s_sleep(1);
        if ((++sp & 255u) == 0u) { if (xb_ld(&bar[XB_TMO])) break; if (sp > XB_SPIN_CAP) { atomicAdd(&bar[XB_TMO], 1u); break; } }
    }
    nloc = mine > 0u ? mine : 1u; nx = cnt > 0u ? cnt : 1u;
}

__device__ __forceinline__ void xcd_barrier(const XcdBarrier& b, const int tid) {
    asm volatile("s_waitcnt vmcnt(0)" ::: "memory");
    __syncthreads();
    if (tid == 0) {
        unsigned* bar = b.bar;
        __builtin_amdgcn_s_waitcnt(0);
        unsigned nloc = b.st[0], nx = b.st[1];
        if (nloc == 0u) { xcd_barrier_complete(bar, b.x, nloc, nx); b.st[0] = nloc; b.st[1] = nx; }
        const unsigned old = xb_add(&bar[XB_XSUB(b.x)], 1u);
        const unsigned gen = old / nloc;
        if (old + 1u == (gen + 1u) * nloc) {
            __builtin_amdgcn_fence(__ATOMIC_RELEASE, "agent");
            asm volatile("s_waitcnt vmcnt(0)" ::: "memory");
            const unsigned og = xb_add(&bar[XB_TOP], 1u);
            const unsigned tg = og / nx;
            if (og + 1u == (tg + 1u) * nx) xb_add(&bar[XB_TOPGEN], 1u);
            else XB_SPIN(xb_ld(&bar[XB_TOPGEN]) == tg, bar);
            __builtin_amdgcn_fence(__ATOMIC_ACQUIRE, "agent");
            xb_add(&bar[XB_XGEN(b.x)], 1u);
            asm volatile("s_waitcnt vmcnt(0)" ::: "memory");
        } else {
            XB_SPIN(xb_ld(&bar[XB_XGEN(b.x)]) == gen, bar);
            __builtin_amdgcn_fence(__ATOMIC_ACQUIRE, "agent");
            asm volatile("s_waitcnt vmcnt(0)" ::: "memory");
        }
    }
    __syncthreads();
}


constexpr int NWAVES = 8, NTHREADS = 512;
constexpr int D = 1024, SEQ = 8192, NMETA = 16, DECB = 128, DECT = 8, DEPTH = 2;
constexpr int R_SAMPLE = 16384, R_META = 17408, MROWS = 17440, MPAD = 17664;
constexpr int NPROJ = 3584, DFF = 2816, NFF2 = 5632, DIN = 3596;
constexpr int C_DNQ = 0, C_DNK = 512, C_DNV = 1024, C_DNZ = 1536, C_SSX = 2048, C_SSZ = 2816, C_SWQ = 3072, C_SWK = 3328, C_SWV = 3456;
constexpr int NCHUNK = 129;
constexpr int NSWAB = 65;
constexpr float EPS = 1e-6f;
enum { I_XP = 0, I_XS, I_SDN, I_SDNC, I_SSSM, I_SSSMC, I_CK, I_CV, I_META, I_WIN, I_DNCW, I_DNALOG, I_DNDTB, I_DNNW, I_SSCW, I_SSCB, I_SSALOG, I_SSDTB, I_SSD, I_SSNW, I_SINK,
       I_WOUT, I_GPM, I_GPOM, I_GPF, I_GPOF, I_WFI, I_WFO, N_IN };
constexpr size_t O_YP = 0, O_YS = O_YP + (size_t)2 * SEQ * D, O_DNP = O_YS + (size_t)DECB * DECT * D, O_DNCP = O_DNP + 2 * 2 * 4 * 128 * 128, O_SSMP = O_DNCP + 2 * 2 * 3 * 1536,
                 O_SSMCP = O_SSMP + 2 * 2 * 4 * 64 * 128, O_KP = O_SSMCP + 2 * 2 * 3 * 768, O_VP = O_KP + 2 * 2 * 128 * 128, O_DNS = O_VP + 2 * 2 * 128 * 128,
                 O_DNCS = O_DNS + (size_t)2 * DECB * 4 * 128 * 128, O_SSMS = O_DNCS + (size_t)2 * DECB * 3 * 1536, O_SSMCS = O_SSMS + (size_t)2 * DECB * 4 * 64 * 128,
                 O_KS = O_SSMCS + (size_t)2 * DECB * 3 * 768, O_VS = O_KS + (size_t)2 * DECB * 128 * 128, O_END = O_VS + (size_t)2 * DECB * 128 * 128;
constexpr size_t MiB = 1u << 20;
constexpr size_t WS_CTL = 0, CTL_ZERO_BYTES = 64 * 1024;
constexpr size_t WS_DNGL = 512 * 1024, WS_SSGL = 640 * 1024;
constexpr size_t WS_SMALL = 1 * MiB;
constexpr size_t WS_XMETA = 3 * MiB;
constexpr size_t WS_WIN = 4 * MiB;
constexpr size_t WS_MIXED = 11 * MiB;
constexpr size_t WS_PROJ = 46 * MiB;
constexpr size_t WS_XN = 167 * MiB;
constexpr size_t WS_MOUT = 202 * MiB;
constexpr size_t WS_SSMREC = 167 * MiB;
constexpr size_t DNREC_BYTES = 73728, SSMREC_BYTES = 49152;
constexpr size_t WS_DNREC1 = 216 * MiB; constexpr int DNREC1_N = 298;
constexpr size_t WS_DNREC2 = 237 * MiB;
constexpr size_t WS_WOUT = 237 * MiB, WS_WFI = 239 * MiB, WS_WFO = 250 * MiB;
constexpr size_t WS_END = 289 * MiB;
static_assert(WS_SSMREC + (size_t)1032 * SSMREC_BYTES <= WS_DNREC1 && WS_DNREC1 + (size_t)DNREC1_N * DNREC_BYTES <= WS_DNREC2 && WS_DNREC2 + (size_t)(1032 - DNREC1_N) * DNREC_BYTES <= WS_END, "ws map");
static_assert(WS_MIXED + (size_t)MPAD * 1024 * 2 <= WS_PROJ && WS_PROJ + (size_t)MPAD * NPROJ * 2 <= WS_XN && WS_XN + (size_t)MPAD * 2048 <= WS_MOUT && WS_MOUT + (size_t)MPAD * 2048 <= WS_DNREC2, "ws map 2");
static_assert(WS_WFO + (size_t)1024 * DFF * 2 <= WS_END && WS_WFI + (size_t)NFF2 * 1024 * 2 <= WS_WFO, "ws map 3");
constexpr int CW_TMO = 0, CW_BAR = 1024;
constexpr int R_W = 0, R_QD = 16384, R_KDT = 32768, R_ATT = 49152, R_UT = 57344;
constexpr int S_CD = 0, S_BDT = 16384, S_XDTT = 32768, S_YIN = 40960;
constexpr int LDS_BYTES = 160 * 1024;
constexpr int LDSCTL_OFF = 159 * 1024;

typedef short bf16x4 __attribute__((ext_vector_type(4)));
typedef unsigned u32x2 __attribute__((ext_vector_type(2)));

__device__ __forceinline__ float bf2f(unsigned short h) { return __uint_as_float((unsigned)h << 16); }
__device__ __forceinline__ float bflo(unsigned u) { return __uint_as_float(u << 16); }
__device__ __forceinline__ float bfhi(unsigned u) { return __uint_as_float(u & 0xffff0000u); }
__device__ __forceinline__ float siluf(float x) { return x * __builtin_amdgcn_rcpf(1.f + __expf(-x)); }
__device__ __forceinline__ float sigmoidf_(float x) { return __builtin_amdgcn_rcpf(1.f + __expf(-x)); }
__device__ __forceinline__ float softplusf_(float x) { const float e = __expf(x); return x > 20.f ? x : (e < 1e-3f ? e * (1.f - 0.5f * e) : __logf(1.f + e)); }
__device__ __forceinline__ f32x4 mma16(bf16x8 x, bf16x8 y, f32x4 c) { return __builtin_amdgcn_mfma_f32_16x16x32_bf16(x, y, c, 0, 0, 0); }
__device__ __forceinline__ int swz(int row, int byte, int RB) { return row * RB + (byte ^ ((row & 7) << 4)); }
__device__ __forceinline__ int row_of_tp(int b, int tp) { return tp < 16 ? R_META + b * 16 + tp : b * SEQ + tp - 16; }
__device__ __forceinline__ v4u pack8(const float* v) { v4u o; o.x = pk2(v[0], v[1]); o.y = pk2(v[2], v[3]); o.z = pk2(v[4], v[5]); o.w = pk2(v[6], v[7]); return o; }
__device__ __forceinline__ u32x2 pack4(float a, float b, float c, float d) { u32x2 o; o.x = pk2(a, b); o.y = pk2(c, d); return o; }
__device__ __forceinline__ void unpack8(v4u r, float* v) { v[0] = bflo(r.x); v[1] = bfhi(r.x); v[2] = bflo(r.y); v[3] = bfhi(r.y); v[4] = bflo(r.z); v[5] = bfhi(r.z); v[6] = bflo(r.w); v[7] = bfhi(r.w); }
__device__ __forceinline__ float wave_sum(float v) {
#pragma unroll
    for (int o = 1; o < 64; o <<= 1) v += __shfl_xor(v, o);
    return v;
}
__device__ __forceinline__ float wave_max(float v) {
#pragma unroll
    for (int o = 1; o < 64; o <<= 1) v = fmaxf(v, __shfl_xor(v, o));
    return v;
}
__device__ __forceinline__ float wave_incl_scan(float v, int lane) {
#pragma unroll
    for (int o = 1; o < 64; o <<= 1) { const float t = __shfl_up(v, o); if (lane >= o) v += t; }
    return v;
}
#define BAR_LDS() do { asm volatile("s_waitcnt lgkmcnt(0)" ::: "memory"); __builtin_amdgcn_s_barrier(); asm volatile("" ::: "memory"); } while (0)
#define BAR_ALL() do { asm volatile("s_waitcnt vmcnt(0) lgkmcnt(0)" ::: "memory"); __builtin_amdgcn_s_barrier(); asm volatile("" ::: "memory"); } while (0)

struct Args { const float* in[N_IN]; float* out; unsigned char* ws; int ph_lo, ph_hi; };
typedef const __attribute__((address_space(4))) Args* KaPtr;
struct KaIn { KaPtr ka; __device__ __forceinline__ const float* operator[](int i) const { return ka->in[i]; } };
struct Frame {
    LAS unsigned char* lds;
    int tid, lane, wave, vcu, G;
    KaIn in;
    float* out; unsigned char* ws;
};
__device__ __forceinline__ unsigned char* dnrec_ptr(unsigned char* ws, int b, int c, int h) { const int r = (b * NCHUNK + c) * 4 + h; return r < DNREC1_N ? ws + WS_DNREC1 + (size_t)r * DNREC_BYTES : ws + WS_DNREC2 + (size_t)(r - DNREC1_N) * DNREC_BYTES; }
__device__ __forceinline__ unsigned char* ssmrec_ptr(unsigned char* ws, int b, int c, int h) { return ws + WS_SSMREC + (size_t)((b * NCHUNK + c) * 4 + h) * SSMREC_BYTES; }
__device__ __forceinline__ float* xres_row(Frame& F, int row) { return row < R_META ? F.out + (size_t)row * D : (float*)(F.ws + WS_XMETA) + (size_t)(row - R_META) * D; }
__device__ __forceinline__ const float* xin_row(Frame& F, int row) { return row < R_SAMPLE ? F.in[I_XP] + (size_t)row * D : row < R_META ? F.in[I_XS] + (size_t)(row - R_SAMPLE) * D : F.in[I_META] + (size_t)((row - R_META) & 15) * D; }

__device__ __forceinline__ void transpose_item(const float* W, int ldw, int K, int srccol0, bf16* WT, int dstrow0, int k0, LAS float* scr, int lane) {
#pragma unroll 8
    for (int i = 0; i < 32; ++i) { const int kk = 2 * i + (lane >> 5); scr[kk * 33 + (lane & 31)] = W[(size_t)(k0 + kk) * ldw + srccol0 + (lane & 31)]; }
    LDS_WAIT(); asm volatile("" ::: "memory");
    const int c = lane & 7;
#pragma unroll
    for (int j = 0; j < 4; ++j) { const int n = (lane >> 3) + 8 * j; const LAS float* s = scr + (8 * c) * 33 + n;
        v4u o; o.x = pk2(s[0 * 33], s[1 * 33]); o.y = pk2(s[2 * 33], s[3 * 33]); o.z = pk2(s[4 * 33], s[5 * 33]); o.w = pk2(s[6 * 33], s[7 * 33]);
        *(v4u*)(WT + (size_t)(dstrow0 + n) * K + k0 + 8 * c) = o; }
    LDS_WAIT(); asm volatile("" ::: "memory");
}
__device__ __forceinline__ void convert_weight(Frame& F, int which, int l, int gw, int NGW) {
    LAS float* scr = (LAS float*)(F.lds + F.wave * 16384);
    const float* W; int ldw, K, N; bf16* WT;
    if (which == 0) { W = F.in[I_WIN] + (size_t)l * D * DIN; ldw = DIN; K = D; N = NPROJ; WT = (bf16*)(F.ws + WS_WIN); }
    else if (which == 1) { W = F.in[I_WOUT] + (size_t)l * D * D; ldw = D; K = D; N = D; WT = (bf16*)(F.ws + WS_WOUT); }
    else if (which == 2) { W = F.in[I_WFI] + (size_t)l * D * NFF2; ldw = NFF2; K = D; N = NFF2; WT = (bf16*)(F.ws + WS_WFI); }
    else { W = F.in[I_WFO] + (size_t)l * DFF * D; ldw = D; K = DFF; N = D; WT = (bf16*)(F.ws + WS_WFO); }
    const int nblk = N / 32, nitems = (K / 64) * nblk;
    for (int it = gw; it < nitems; it += NGW) {
        const int kb = it / nblk, nb = it % nblk, base = 32 * nb; int src;
        if (which == 0) src = base + (base >= 3072 ? 12 : base >= 2048 ? 8 : 0);
        else if (which == 2) { const int tile = base >> 8, within = base & 255; src = within < 128 ? 128 * tile + within : DFF + 128 * tile + within - 128; }
        else src = base;
        transpose_item(W, ldw, K, src, WT, base, 64 * kb, scr, F.lane);
    }
}

template <int MODE> __device__ __forceinline__ void phase_norm(Frame& F, int l) {
    const bool do_small = (MODE == 0) || (MODE == 2 && l == 0);
    const bool do_xn = (MODE != 2) || (l == 0);
    const int lw = (MODE == 0) ? 0 : 1;
    LAS float* wsm = (LAS float*)F.lds;
    __syncthreads();
    if (do_small) {
        const float* W = F.in[I_WIN] + (size_t)lw * D * DIN;
        for (int idx = F.tid; idx < 12 * 1024; idx += NTHREADS) { const int k = idx / 12, cc = idx % 12; wsm[cc * 1024 + k] = W[(size_t)k * DIN + (cc < 8 ? 2048 + cc : 3080 + cc - 8)]; }
    }
    __syncthreads();
    const float* gpost = MODE == 1 ? F.in[I_GPOM] + l * D : F.in[I_GPOF] + l * D;
    const float* gnext = MODE == 0 ? F.in[I_GPM] : MODE == 1 ? F.in[I_GPF] + l * D : F.in[I_GPM] + D;
    const bf16* MOUT = (const bf16*)(F.ws + WS_MOUT); bf16* XN = (bf16*)(F.ws + WS_XN); float* SMALL = (float*)(F.ws + WS_SMALL);
    const int gw = F.vcu * NWAVES + F.wave, NGW = F.G * NWAVES, lane = F.lane;
    for (int row = gw; row < MROWS; row += NGW) {
        f32x4 v[4];
        const float* xs = (MODE == 0 || (MODE == 1 && l == 0)) ? xin_row(F, row) : xres_row(F, row);
#pragma unroll
        for (int j = 0; j < 4; ++j) v[j] = *(const f32x4*)(xs + lane * 4 + 256 * j);
        if (MODE != 0) {
            f32x4 m[4]; float ss = 0.f;
#pragma unroll
            for (int j = 0; j < 4; ++j) { const u32x2 r = *(const u32x2*)(MOUT + (size_t)row * D + lane * 4 + 256 * j); m[j] = (f32x4){bflo(r.x), bfhi(r.x), bflo(r.y), bfhi(r.y)};
                ss += (m[j].x * m[j].x + m[j].y * m[j].y) + (m[j].z * m[j].z + m[j].w * m[j].w); }
            const float rs = rsqrtf(wave_sum(ss) * (1.f / D) + EPS);
            float* xo = xres_row(F, row);
#pragma unroll
            for (int j = 0; j < 4; ++j) { const f32x4 g = *(const f32x4*)(gpost + lane * 4 + 256 * j); v[j] = v[j] + m[j] * rs * g; *(f32x4*)(xo + lane * 4 + 256 * j) = v[j]; }
        }
        if (do_xn) {
            float ss = 0.f;
#pragma unroll
            for (int j = 0; j < 4; ++j) ss += (v[j].x * v[j].x + v[j].y * v[j].y) + (v[j].z * v[j].z + v[j].w * v[j].w);
            const float rs = rsqrtf(wave_sum(ss) * (1.f / D) + EPS);
#pragma unroll
            for (int j = 0; j < 4; ++j) { const f32x4 g = *(const f32x4*)(gnext + lane * 4 + 256 * j); v[j] = v[j] * rs * g;
                *(u32x2*)(XN + (size_t)row * D + lane * 4 + 256 * j) = pack4(v[j].x, v[j].y, v[j].z, v[j].w); }
            if (do_small) {
#pragma unroll 4
                for (int cc = 0; cc < 12; ++cc) { float p = 0.f;
#pragma unroll
                    for (int j = 0; j < 4; ++j) { const f32x4 w = *(const LAS f32x4*)(wsm + cc * 1024 + lane * 4 + 256 * j); p += (v[j].x * w.x + v[j].y * w.y) + (v[j].z * w.z + v[j].w * w.w); }
                    p = wave_sum(p);
                    if (lane == 0) SMALL[(size_t)row * 16 + cc] = p; }
            }
        }
    }
    __syncthreads();
}


__device__ __forceinline__ void dn1_unit(Frame& F, int l, int b, int c, int h) {
    LAS unsigned char* lds = F.lds;
    constexpr int L_Q = 0, L_K = 16384, L_V = 32768, L_A = 49152, L_GC = 65536, L_BETA = 65792, L_EG = 66048, L_EGL = 66304;
    int tid = F.tid; asm volatile("" : "+v"(tid)); const int lane = tid & 63, wave = __builtin_amdgcn_readfirstlane(tid >> 6);
    const bf16* PROJ = (const bf16*)(F.ws + WS_PROJ);
    unsigned char* rec = dnrec_ptr(F.ws, b, c, h);
    LAS float* GC = (LAS float*)(lds + L_GC); LAS float* BETA = (LAS float*)(lds + L_BETA); LAS float* EG = (LAS float*)(lds + L_EG); LAS float* EGL = (LAS float*)(lds + L_EGL);
    if (tid < 384) {
        const int g16 = tid >> 4, strip = g16 / 3, part = g16 % 3, cgi = tid & 15;
        const int ch = part * 512 + h * 128 + cgi * 8;
        float w[4][8];
        const float* cw = F.in[I_DNCW] + (size_t)l * 4 * 1536 + ch;
#pragma unroll
        for (int i = 0; i < 4; ++i) { const f32x4 a = *(const f32x4*)(cw + i * 1536), b4 = *(const f32x4*)(cw + i * 1536 + 4);
            w[i][0] = a.x; w[i][1] = a.y; w[i][2] = a.z; w[i][3] = a.w; w[i][4] = b4.x; w[i][5] = b4.y; w[i][6] = b4.z; w[i][7] = b4.w; }
        const int tp0 = 64 * c + strip * 8 - 48;
        float win[3][8];
#pragma unroll
        for (int rr = 0; rr < 3; ++rr) { const int tp = tp0 - 3 + rr;
            if (tp >= 0) { const v4u r = *(const v4u*)(PROJ + (size_t)row_of_tp(b, tp) * NPROJ + ch); unpack8(r, win[rr]); }
            else {
#pragma unroll
                for (int e = 0; e < 8; ++e) win[rr][e] = 0.f; } }
        LAS unsigned char* dst = lds + (part == 0 ? L_Q : part == 1 ? L_K : L_V);
#pragma unroll
        for (int tt = 0; tt < 8; ++tt) {
            const int tp = tp0 + tt; float cur[8];
            if (tp >= 0) { const v4u r = *(const v4u*)(PROJ + (size_t)row_of_tp(b, tp) * NPROJ + ch); unpack8(r, cur); }
            else {
#pragma unroll
                for (int e = 0; e < 8; ++e) cur[e] = 0.f; }
            float o[8]; float ss = 0.f;
#pragma unroll
            for (int e = 0; e < 8; ++e) { const float a = w[0][e] * win[0][e] + w[1][e] * win[1][e] + w[2][e] * win[2][e] + w[3][e] * cur[e]; o[e] = (tp >= 0) ? siluf(a) : 0.f; ss += o[e] * o[e];
                win[0][e] = win[1][e]; win[1][e] = win[2][e]; win[2][e] = cur[e]; }
            ss += __shfl_xor(ss, 1); ss += __shfl_xor(ss, 2); ss += __shfl_xor(ss, 4); ss += __shfl_xor(ss, 8);
            if (part < 2) { const float rn = rsqrtf(ss + EPS) * (part == 0 ? 0.08838834764831845f : 1.f);
#pragma unroll
                for (int e = 0; e < 8; ++e) o[e] *= rn; }
            *(LAS v4u*)(dst + swz(strip * 8 + tt, cgi * 16, 256)) = pack8(o);
        }
        if (c == NCHUNK - 1 && strip == 7) {
            float* o = F.out + O_DNCP + (size_t)((l * 2 + b) * 3) * 1536 + ch;
#pragma unroll
            for (int j = 0; j < 3; ++j) { *(f32x4*)(o + j * 1536) = (f32x4){win[j][0], win[j][1], win[j][2], win[j][3]}; *(f32x4*)(o + j * 1536 + 4) = (f32x4){win[j][4], win[j][5], win[j][6], win[j][7]}; }
        }
    } else if (tid >= 448) {
        const int tp = 64 * c + lane - 48; float beta = 0.f, g = 0.f;
        if (tp >= 0) { const float* sm = (const float*)(F.ws + WS_SMALL) + (size_t)row_of_tp(b, tp) * 16;
            beta = sigmoidf_(sm[h]); g = -__expf(F.in[I_DNALOG][l * 4 + h]) * softplusf_(sm[4 + h] + F.in[I_DNDTB][l * 4 + h]); }
        const float gc = wave_incl_scan(g, lane); const float g63 = __shfl(gc, 63);
        GC[lane] = gc; BETA[lane] = beta; EG[lane] = __expf(gc); EGL[lane] = __expf(g63 - gc);
        if (lane == 0) ((float*)(F.ws + WS_DNGL))[(b * 4 + h) * 132 + c] = __expf(g63);
    }
    __syncthreads();
    {
        const int mat = wave >> 2, mi = wave & 3, fr = lane & 15, fq = lane >> 4;
        const int i = 16 * mi + fr; const float gci = GC[i], bi = BETA[i];
        for (int nj = 0; nj < 4; ++nj) {
            f32x4 acc = {0.f, 0.f, 0.f, 0.f};
            if (nj <= mi) {
#pragma unroll
                for (int kk = 0; kk < 4; ++kk) { const bf16x8 x = *(const LAS bf16x8*)(lds + L_K + swz(16 * nj + fr, 64 * kk + 16 * fq, 256));
                    const bf16x8 y = *(const LAS bf16x8*)(lds + (mat == 0 ? L_K : L_Q) + swz(i, 64 * kk + 16 * fq, 256)); acc = mma16(x, y, acc); }
            }
            float o[4];
#pragma unroll
            for (int r = 0; r < 4; ++r) { const int j = 16 * nj + 4 * fq + r; const bool ok = mat == 0 ? (j < i) : (j <= i); o[r] = ok ? acc[r] * __expf(gci - GC[j]) * (mat == 0 ? bi : 1.f) : 0.f; }
            if (mat == 0) *(LAS f32x4*)(lds + L_A + (i * 64 + 16 * nj + 4 * fq) * 4) = (f32x4){o[0], o[1], o[2], o[3]};
            else *(u32x2*)(rec + R_ATT + swz(i, 2 * (16 * nj + 4 * fq), 128)) = pack4(o[0], o[1], o[2], o[3]);
        }
    }
    __syncthreads();
    if (tid < 256) {
        const int cc = tid; float sol[64];
        const int colb = (cc & 127) * 2; const int srcoff = cc < 128 ? L_V : L_K;
#pragma unroll
        for (int i = 0; i < 64; ++i) {
            const float rv = bf2f(*(const LAS unsigned short*)(lds + srcoff + swz(i, colb, 256)));
            const float egi = EG[i]; float a0 = rv * BETA[i] * (cc < 128 ? 1.f : egi), a1 = 0.f, a2 = 0.f, a3 = 0.f;
#pragma unroll
            for (int j4 = 0; j4 < (i + 3) / 4; ++j4) { const f32x4 ar = *(const LAS f32x4*)(lds + L_A + (i * 64 + 4 * j4) * 4);
                if (4 * j4 + 0 < i) a0 -= ar.x * sol[4 * j4 + 0]; if (4 * j4 + 1 < i) a1 -= ar.y * sol[4 * j4 + 1]; if (4 * j4 + 2 < i) a2 -= ar.z * sol[4 * j4 + 2]; if (4 * j4 + 3 < i) a3 -= ar.w * sol[4 * j4 + 3]; }
            float sv = (a0 + a1) + (a2 + a3);
            asm volatile("" : "+v"(sv) :: "memory"); sol[i] = sv;
        }
        if (cc < 128) { unsigned char* ut = rec + R_UT + (cc >> 5) * 4096; const int col = cc & 31;
#pragma unroll
            for (int i0 = 0; i0 < 64; i0 += 8) *(v4u*)(ut + swz(col, 2 * i0, 128)) = pack8(&sol[i0]);
        } else { const int d = cc - 128;
#pragma unroll
            for (int i = 0; i < 64; ++i) *(unsigned short*)(rec + R_W + swz(i, 2 * d, 256)) = (unsigned short)f2bf(sol[i]); }
    } else {
        const int t = tid - 256;
        { const int i = t >> 2, q4 = t & 3; const float e = EG[i];
#pragma unroll
            for (int cchunk = 0; cchunk < 4; ++cchunk) { const int kb = (q4 * 4 + cchunk) * 16; float v[8]; unpack8(*(const LAS v4u*)(lds + L_Q + swz(i, kb, 256)), v);
#pragma unroll
                for (int k = 0; k < 8; ++k) v[k] *= e;
                *(v4u*)(rec + R_QD + swz(i, kb, 256)) = pack8(v); } }
        { const int d = t & 127, ih = t >> 7;
#pragma unroll
            for (int i0 = 0; i0 < 32; i0 += 8) { float v[8];
#pragma unroll
                for (int k = 0; k < 8; ++k) { const int i = 32 * ih + i0 + k; v[k] = bf2f(*(const LAS unsigned short*)(lds + L_K + swz(i, 2 * d, 256))) * EGL[i]; }
                *(v4u*)(rec + R_KDT + swz(d, 2 * (32 * ih + i0), 128)) = pack8(v); } }
    }
    __syncthreads();
}

__device__ __forceinline__ void ssm1_unit(Frame& F, int l, int b, int c, int g) {
    LAS unsigned char* lds = F.lds;
    constexpr int L_XS = 0, L_B = 32768, L_C = 49152, L_CB = 65536, L_ATT = 81920, L_XDTT = 98304, L_DT = 114688, L_GC = 115200, L_EG = 115712, L_EGL = 116224;
    int tid = F.tid; asm volatile("" : "+v"(tid)); const int lane = tid & 63, wave = __builtin_amdgcn_readfirstlane(tid >> 6);
    const bf16* PROJ = (const bf16*)(F.ws + WS_PROJ);
    LAS float* XS = (LAS float*)(lds + L_XS); LAS float* CB = (LAS float*)(lds + L_CB);
    LAS float* DT = (LAS float*)(lds + L_DT); LAS float* GC = (LAS float*)(lds + L_GC); LAS float* EG = (LAS float*)(lds + L_EG); LAS float* EGL = (LAS float*)(lds + L_EGL);
    if (tid < 384) {
        const int g16 = tid >> 4, strip = g16 / 3, part = g16 % 3, cgi = tid & 15;
        const int ch = part * 256 + g * 128 + cgi * 8;
        float w[4][8], bias[8];
        const float* cw = F.in[I_SSCW] + (size_t)l * 4 * 768 + ch;
#pragma unroll
        for (int i = 0; i < 4; ++i) { const f32x4 a = *(const f32x4*)(cw + i * 768), b4 = *(const f32x4*)(cw + i * 768 + 4);
            w[i][0] = a.x; w[i][1] = a.y; w[i][2] = a.z; w[i][3] = a.w; w[i][4] = b4.x; w[i][5] = b4.y; w[i][6] = b4.z; w[i][7] = b4.w; }
        { const float* cb = F.in[I_SSCB] + l * 768 + ch; const f32x4 a = *(const f32x4*)cb, b4 = *(const f32x4*)(cb + 4); bias[0] = a.x; bias[1] = a.y; bias[2] = a.z; bias[3] = a.w; bias[4] = b4.x; bias[5] = b4.y; bias[6] = b4.z; bias[7] = b4.w; }
        const int tp0 = 64 * c + strip * 8 - 48;
        float win[3][8];
#pragma unroll
        for (int rr = 0; rr < 3; ++rr) { const int tp = tp0 - 3 + rr;
            if (tp >= 0) { const v4u r = *(const v4u*)(PROJ + (size_t)row_of_tp(b, tp) * NPROJ + C_SSX + ch); unpack8(r, win[rr]); }
            else {
#pragma unroll
                for (int e = 0; e < 8; ++e) win[rr][e] = 0.f; } }
#pragma unroll
        for (int tt = 0; tt < 8; ++tt) {
            const int tp = tp0 + tt; float cur[8];
            if (tp >= 0) { const v4u r = *(const v4u*)(PROJ + (size_t)row_of_tp(b, tp) * NPROJ + C_SSX + ch); unpack8(r, cur); }
            else {
#pragma unroll
                for (int e = 0; e < 8; ++e) cur[e] = 0.f; }
            float o[8];
#pragma unroll
            for (int e = 0; e < 8; ++e) { const float a = bias[e] + w[0][e] * win[0][e] + w[1][e] * win[1][e] + w[2][e] * win[2][e] + w[3][e] * cur[e]; o[e] = (tp >= 0) ? siluf(a) : 0.f;
                win[0][e] = win[1][e]; win[1][e] = win[2][e]; win[2][e] = cur[e]; }
            const int trow = strip * 8 + tt;
            if (part == 0) { *(LAS f32x4*)(XS + trow * 128 + cgi * 8) = (f32x4){o[0], o[1], o[2], o[3]}; *(LAS f32x4*)(XS + trow * 128 + cgi * 8 + 4) = (f32x4){o[4], o[5], o[6], o[7]}; }
            else *(LAS v4u*)(lds + (part == 1 ? L_B : L_C) + swz(trow, cgi * 16, 256)) = pack8(o);
        }
        if (c == NCHUNK - 1 && strip == 7) {
            float* o = F.out + O_SSMCP + (size_t)((l * 2 + b) * 3) * 768 + ch;
#pragma unroll
            for (int j = 0; j < 3; ++j) { *(f32x4*)(o + j * 768) = (f32x4){win[j][0], win[j][1], win[j][2], win[j][3]}; *(f32x4*)(o + j * 768 + 4) = (f32x4){win[j][4], win[j][5], win[j][6], win[j][7]}; }
        }
    } else if (tid >= 448) {
        const int tp = 64 * c + lane - 48;
#pragma unroll
        for (int hh = 0; hh < 2; ++hh) { const int h = 2 * g + hh; float dt = 0.f;
            if (tp >= 0) dt = softplusf_(((const float*)(F.ws + WS_SMALL))[(size_t)row_of_tp(b, tp) * 16 + 8 + h] + F.in[I_SSDTB][l * 4 + h]);
            const float a = -__expf(F.in[I_SSALOG][l * 4 + h]) * dt;
            const float gc = wave_incl_scan(a, lane); const float g63 = __shfl(gc, 63);
            DT[hh * 64 + lane] = dt; GC[hh * 64 + lane] = gc; EG[hh * 64 + lane] = __expf(gc); EGL[hh * 64 + lane] = __expf(g63 - gc);
            if (lane == 0) ((float*)(F.ws + WS_SSGL))[(b * 4 + h) * 132 + c] = __expf(g63); }
    }
    __syncthreads();
    {
        const int fr = lane & 15, fq = lane >> 4;
#pragma unroll
        for (int tq = 0; tq < 2; ++tq) { const int t = 2 * wave + tq, mi = t >> 2, nj = t & 3;
            if (nj <= mi) { f32x4 acc = {0.f, 0.f, 0.f, 0.f};
#pragma unroll
                for (int kk = 0; kk < 4; ++kk) { const bf16x8 x = *(const LAS bf16x8*)(lds + L_B + swz(16 * nj + fr, 64 * kk + 16 * fq, 256)); const bf16x8 y = *(const LAS bf16x8*)(lds + L_C + swz(16 * mi + fr, 64 * kk + 16 * fq, 256)); acc = mma16(x, y, acc); }
                *(LAS f32x4*)(CB + (16 * mi + fr) * 64 + 16 * nj + 4 * fq) = acc; } }
        const int hh = tid >> 8, p = (tid & 255) >> 2, tq4 = tid & 3;
#pragma unroll
        for (int t0 = 0; t0 < 16; t0 += 8) { float v[8];
#pragma unroll
            for (int k = 0; k < 8; ++k) { const int t = 16 * tq4 + t0 + k; v[k] = XS[t * 128 + hh * 64 + p] * DT[hh * 64 + t]; }
            *(LAS v4u*)(lds + L_XDTT + hh * 8192 + swz(p, 2 * (16 * tq4 + t0), 128)) = pack8(v); }
    }
    __syncthreads();
    {
        const int hh = tid >> 8, i = (tid & 255) >> 2, jq = tid & 3; const float gci = GC[hh * 64 + i];
#pragma unroll
        for (int j0 = 0; j0 < 16; j0 += 8) { float v[8];
#pragma unroll
            for (int k = 0; k < 8; ++k) { const int j = 16 * jq + j0 + k; v[k] = (j <= i) ? CB[i * 64 + j] * __expf(gci - GC[hh * 64 + j]) : 0.f; }
            *(LAS v4u*)(lds + L_ATT + hh * 8192 + swz(i, 2 * (16 * jq + j0), 128)) = pack8(v); }
    }
    __syncthreads();
    {
        const int fr = lane & 15, fq = lane >> 4;
        const int hh = wave >> 2, mi = wave & 3, h = 2 * g + hh;
        unsigned char* rec = ssmrec_ptr(F.ws, b, c, h);
        const float Dh = F.in[I_SSD][l * 4 + h];
        const int i = 16 * mi + fr;
#pragma unroll
        for (int pt = 0; pt < 4; ++pt) { f32x4 acc = {0.f, 0.f, 0.f, 0.f};
#pragma unroll
            for (int kk = 0; kk < 2; ++kk) { const bf16x8 x = *(const LAS bf16x8*)(lds + L_XDTT + hh * 8192 + swz(16 * pt + fr, 64 * kk + 16 * fq, 128)); const bf16x8 y = *(const LAS bf16x8*)(lds + L_ATT + hh * 8192 + swz(i, 64 * kk + 16 * fq, 128)); acc = mma16(x, y, acc); }
            const f32x4 xv = *(const LAS f32x4*)(XS + i * 128 + hh * 64 + 16 * pt + 4 * fq);
            *(u32x2*)(rec + S_YIN + swz(i, 2 * (16 * pt + 4 * fq), 128)) = pack4(acc[0] + xv.x * Dh, acc[1] + xv.y * Dh, acc[2] + xv.z * Dh, acc[3] + xv.w * Dh); }
    }
    {
        const int hh = tid >> 8, h = 2 * g + hh, t = tid & 255;
        unsigned char* rec = ssmrec_ptr(F.ws, b, c, h);
        { const int i = t >> 2, q4 = t & 3; const float e = EG[hh * 64 + i];
#pragma unroll
            for (int cchunk = 0; cchunk < 4; ++cchunk) { const int kb = (q4 * 4 + cchunk) * 16; float v[8]; unpack8(*(const LAS v4u*)(lds + L_C + swz(i, kb, 256)), v);
#pragma unroll
                for (int k = 0; k < 8; ++k) v[k] *= e;
                *(v4u*)(rec + S_CD + swz(i, kb, 256)) = pack8(v); } }
        { const int s = t >> 1, th = t & 1;
#pragma unroll
            for (int i0 = 0; i0 < 32; i0 += 8) { float v[8];
#pragma unroll
                for (int k = 0; k < 8; ++k) { const int i = 32 * th + i0 + k; v[k] = bf2f(*(const LAS unsigned short*)(lds + L_B + swz(i, 2 * s, 256))) * EGL[hh * 64 + i]; }
                *(v4u*)(rec + S_BDT + swz(s, 2 * (32 * th + i0), 128)) = pack8(v); } }
        { *(v4u*)(rec + S_XDTT + t * 32) = *(const LAS v4u*)(lds + L_XDTT + hh * 8192 + t * 32); *(v4u*)(rec + S_XDTT + t * 32 + 16) = *(const LAS v4u*)(lds + L_XDTT + hh * 8192 + t * 32 + 16); }
    }
    __syncthreads();
}
__device__ __forceinline__ void phase_m1(Frame& F, int l) {
    constexpr int NDN = 2 * NCHUNK * 4, NSS = 2 * NCHUNK * 2;
#pragma unroll 1
    for (int u = F.vcu; u < NDN; u += F.G) { const int b = u / (NCHUNK * 4), rem = u % (NCHUNK * 4); dn1_unit(F, l, b, rem >> 2, rem & 3); }
#pragma unroll 1
    for (int v = (F.vcu + F.G - 8) % F.G; v < NSS; v += F.G) { const int b = v / (NCHUNK * 2), rem = v % (NCHUNK * 2); ssm1_unit(F, l, b, rem >> 1, rem & 1); }
}


__device__ __forceinline__ void dma1k(const unsigned char* gsrc, LAS unsigned char* ldst, int lane) {
    __builtin_amdgcn_global_load_lds((const unsigned*)(gsrc + lane * 16), (LAS unsigned*)ldst, 16, 0, 0);
}
__device__ __forceinline__ void dn_scan(Frame& F, int l, int b, int h, int s) {
    LAS unsigned char* lds = F.lds;
    constexpr int BUFSZ = 61440, L_ST = 2 * BUFSZ, L_VNT = L_ST + 8192, L_GL = L_VNT + 4096;
    int tid = F.tid; asm volatile("" : "+v"(tid)); const int lane = tid & 63, wave = __builtin_amdgcn_readfirstlane(tid >> 6), fr = lane & 15, fq = lane >> 4;
    bf16* MIXED = (bf16*)(F.ws + WS_MIXED);
    for (int i = tid; i < 8192 / 16; i += NTHREADS) *(LAS v4u*)(lds + L_ST + i * 16) = (v4u){0u, 0u, 0u, 0u};
    if (tid < NCHUNK) ((LAS float*)(lds + L_GL))[tid] = ((const float*)(F.ws + WS_DNGL))[(b * 4 + h) * 132 + tid];
    asm volatile("s_waitcnt vmcnt(0)" ::: "memory");
#define DN_ISSUE(cidx, buf) do { const unsigned char* rec_ = dnrec_ptr(F.ws, b, (cidx), h); LAS unsigned char* dst_ = lds + (buf) * BUFSZ; \
        for (int p_ = wave; p_ < 60; p_ += 8) { const int so_ = p_ < 56 ? p_ * 1024 : R_UT + s * 4096 + (p_ - 56) * 1024; dma1k(rec_ + so_, dst_ + p_ * 1024, lane); } } while (0)
    DN_ISSUE(0, 0);
    f32x4 accs[2] = {{0.f, 0.f, 0.f, 0.f}, {0.f, 0.f, 0.f, 0.f}};
    BAR_ALL();
    const int mt = wave & 3, nt = wave >> 2;
    for (int c = 0; c < NCHUNK; ++c) {
        LAS unsigned char* B = lds + (c & 1) * BUFSZ;
        if (c + 1 < NCHUNK) DN_ISSUE(c + 1, (c + 1) & 1);
        f32x4 accv, acco = {0.f, 0.f, 0.f, 0.f};
        { const bf16x4 u4 = *(const LAS bf16x4*)(B + R_UT + swz(16 * nt + fr, 2 * (16 * mt + 4 * fq), 128));
          accv = (f32x4){-bf2f((unsigned short)u4[0]), -bf2f((unsigned short)u4[1]), -bf2f((unsigned short)u4[2]), -bf2f((unsigned short)u4[3])}; }
#pragma unroll
        for (int kk = 0; kk < 4; ++kk) {
            const bf16x8 st = *(const LAS bf16x8*)(lds + L_ST + swz(16 * nt + fr, 64 * kk + 16 * fq, 256));
            const bf16x8 wf = *(const LAS bf16x8*)(B + R_W + swz(16 * mt + fr, 64 * kk + 16 * fq, 256));
            const bf16x8 qf = *(const LAS bf16x8*)(B + R_QD + swz(16 * mt + fr, 64 * kk + 16 * fq, 256));
            accv = mma16(wf, st, accv);
            acco = mma16(st, qf, acco);
        }
        *(LAS u32x2*)(lds + L_VNT + swz(16 * nt + fr, 2 * (16 * mt + 4 * fq), 128)) = pack4(-accv[0], -accv[1], -accv[2], -accv[3]);
        BAR_LDS();
        bf16x8 vn[2][2];
#pragma unroll
        for (int n2 = 0; n2 < 2; ++n2)
#pragma unroll
            for (int kk = 0; kk < 2; ++kk) vn[n2][kk] = *(const LAS bf16x8*)(lds + L_VNT + swz(16 * n2 + fr, 64 * kk + 16 * fq, 128));
#pragma unroll
        for (int kk = 0; kk < 2; ++kk) { const bf16x8 af = *(const LAS bf16x8*)(B + R_ATT + swz(16 * mt + fr, 64 * kk + 16 * fq, 128)); acco = mma16(nt == 0 ? vn[0][kk] : vn[1][kk], af, acco); }
        { const int tp = 64 * c + 16 * mt + fr - 48;
          if (tp >= 0) *(u32x2*)(MIXED + (size_t)row_of_tp(b, tp) * D + h * 128 + 32 * s + 16 * nt + 4 * fq) = pack4(acco[0], acco[1], acco[2], acco[3]); }
        const float gl = ((const LAS float*)(lds + L_GL))[c];
#pragma unroll
        for (int n2 = 0; n2 < 2; ++n2) { accs[n2] = accs[n2] * gl;
#pragma unroll
            for (int kk = 0; kk < 2; ++kk) { const bf16x8 kf = *(const LAS bf16x8*)(B + R_KDT + swz(16 * wave + fr, 64 * kk + 16 * fq, 128)); accs[n2] = mma16(kf, vn[n2][kk], accs[n2]); }
            *(LAS u32x2*)(lds + L_ST + swz(16 * n2 + fr, 2 * (16 * wave + 4 * fq), 256)) = pack4(accs[n2][0], accs[n2][1], accs[n2][2], accs[n2][3]); }
        BAR_ALL();
    }
#undef DN_ISSUE
    float* o = F.out + O_DNP + (size_t)((l * 2 + b) * 4 + h) * 128 * 128;
#pragma unroll
    for (int n2 = 0; n2 < 2; ++n2)
#pragma unroll
        for (int r = 0; r < 4; ++r) o[(size_t)(16 * wave + 4 * fq + r) * 128 + 32 * s + 16 * n2 + fr] = accs[n2][r];
    __syncthreads();
}
__device__ __forceinline__ void ssm_scan(Frame& F, int l, int b, int h) {
    LAS unsigned char* lds = F.lds;
    constexpr int BUFSZ = 49152, L_HS = 2 * BUFSZ, L_GL = L_HS + 16384;
    int tid = F.tid; asm volatile("" : "+v"(tid)); const int lane = tid & 63, wave = __builtin_amdgcn_readfirstlane(tid >> 6), fr = lane & 15, fq = lane >> 4;
    bf16* MIXED = (bf16*)(F.ws + WS_MIXED);
    for (int i = tid; i < 16384 / 16; i += NTHREADS) *(LAS v4u*)(lds + L_HS + i * 16) = (v4u){0u, 0u, 0u, 0u};
    if (tid < NCHUNK) ((LAS float*)(lds + L_GL))[tid] = ((const float*)(F.ws + WS_SSGL))[(b * 4 + h) * 132 + tid];
    asm volatile("s_waitcnt vmcnt(0)" ::: "memory");
#define SS_ISSUE(cidx, buf) do { const unsigned char* rec_ = ssmrec_ptr(F.ws, b, (cidx), h); LAS unsigned char* dst_ = lds + (buf) * BUFSZ; \
        for (int p_ = wave; p_ < 48; p_ += 8) dma1k(rec_ + p_ * 1024, dst_ + p_ * 1024, lane); } while (0)
    SS_ISSUE(0, 0);
    f32x4 acch[4];
#pragma unroll
    for (int i = 0; i < 4; ++i) acch[i] = (f32x4){0.f, 0.f, 0.f, 0.f};
    BAR_ALL();
    const int tt = wave & 3, ph = wave >> 2;
    for (int c = 0; c < NCHUNK; ++c) {
        LAS unsigned char* B = lds + (c & 1) * BUFSZ;
        if (c + 1 < NCHUNK) SS_ISSUE(c + 1, (c + 1) & 1);
        f32x4 accy[2] = {{0.f, 0.f, 0.f, 0.f}, {0.f, 0.f, 0.f, 0.f}};
#pragma unroll
        for (int kk = 0; kk < 4; ++kk) { const bf16x8 cf = *(const LAS bf16x8*)(B + S_CD + swz(16 * tt + fr, 64 * kk + 16 * fq, 256));
#pragma unroll
            for (int j = 0; j < 2; ++j) { const bf16x8 hf = *(const LAS bf16x8*)(lds + L_HS + swz(16 * (2 * ph + j) + fr, 64 * kk + 16 * fq, 256)); accy[j] = mma16(hf, cf, accy[j]); } }
        { const int tp = 64 * c + 16 * tt + fr - 48;
#pragma unroll
          for (int j = 0; j < 2; ++j) { const int p0 = 16 * (2 * ph + j) + 4 * fq; const bf16x4 y4 = *(const LAS bf16x4*)(B + S_YIN + swz(16 * tt + fr, 2 * p0, 128));
            if (tp >= 0) *(u32x2*)(MIXED + (size_t)row_of_tp(b, tp) * D + 512 + h * 64 + p0) =
                pack4(accy[j][0] + bf2f((unsigned short)y4[0]), accy[j][1] + bf2f((unsigned short)y4[1]), accy[j][2] + bf2f((unsigned short)y4[2]), accy[j][3] + bf2f((unsigned short)y4[3])); } }
        BAR_LDS();
        const float gl = ((const LAS float*)(lds + L_GL))[c];
#pragma unroll
        for (int pt = 0; pt < 4; ++pt) { acch[pt] = acch[pt] * gl;
#pragma unroll
            for (int kk = 0; kk < 2; ++kk) { const bf16x8 bf = *(const LAS bf16x8*)(B + S_BDT + swz(16 * wave + fr, 64 * kk + 16 * fq, 128)); const bf16x8 xf = *(const LAS bf16x8*)(B + S_XDTT + swz(16 * pt + fr, 64 * kk + 16 * fq, 128)); acch[pt] = mma16(bf, xf, acch[pt]); }
            *(LAS u32x2*)(lds + L_HS + swz(16 * pt + fr, 2 * (16 * wave + 4 * fq), 256)) = pack4(acch[pt][0], acch[pt][1], acch[pt][2], acch[pt][3]); }
        BAR_ALL();
    }
#undef SS_ISSUE
    float* o = F.out + O_SSMP + (size_t)((l * 2 + b) * 4 + h) * 64 * 128;
#pragma unroll
    for (int pt = 0; pt < 4; ++pt) *(f32x4*)(o + (size_t)(16 * pt + fr) * 128 + 16 * wave + 4 * fq) = acch[pt];
    __syncthreads();
}

__device__ __forceinline__ float rope_inv(int j) { return exp2f(-(float)j * 0.4152410118609203f); }

__device__ __forceinline__ void swa_unit(Frame& F, int l, int b, int n, int kvh) {
    LAS unsigned char* lds = F.lds;
    constexpr int L_Q = 0, L_K = 36864, L_VT = 73728;
    int tid = F.tid; asm volatile("" : "+v"(tid)); const int lane = tid & 63, wave = __builtin_amdgcn_readfirstlane(tid >> 6), fr = lane & 15, fq = lane >> 4;
    const bf16* PROJ = (const bf16*)(F.ws + WS_PROJ); bf16* MIXED = (bf16*)(F.ws + WS_MIXED);
#pragma unroll
    for (int it = 0; it < 4; ++it) {
        const int id = tid + 512 * (it & 1), r = id >> 2, jj = id & 3; const bool isq = it < 2;
        const int p = isq ? 128 * n + (r & 127) : 128 * (n - 1) + r; const bool ok = p >= 112;
        float o1[8], o2[8];
        if (ok) { const int row = row_of_tp(b, p - 112); const int col = isq ? C_SWQ + (2 * kvh + (r >> 7)) * 64 : C_SWK + kvh * 64;
            float x1[8], x2[8]; unpack8(*(const v4u*)(PROJ + (size_t)row * NPROJ + col + 8 * jj), x1); unpack8(*(const v4u*)(PROJ + (size_t)row * NPROJ + col + 32 + 8 * jj), x2);
            const float pos = (float)(p - 112);
#pragma unroll
            for (int e = 0; e < 8; ++e) { float sn, cs; sincosf(pos * rope_inv(8 * jj + e), &sn, &cs); o1[e] = x1[e] * cs - x2[e] * sn; o2[e] = x2[e] * cs + x1[e] * sn; }
            if (!isq && n == NSWAB - 1 && r >= 128) { float* ko = F.out + O_KP + (size_t)(((l * 2 + b) * 128 + (r - 128)) * 2 + kvh) * 64;
                *(f32x4*)(ko + 8 * jj) = (f32x4){o1[0], o1[1], o1[2], o1[3]}; *(f32x4*)(ko + 8 * jj + 4) = (f32x4){o1[4], o1[5], o1[6], o1[7]};
                *(f32x4*)(ko + 32 + 8 * jj) = (f32x4){o2[0], o2[1], o2[2], o2[3]}; *(f32x4*)(ko + 32 + 8 * jj + 4) = (f32x4){o2[4], o2[5], o2[6], o2[7]}; }
        } else {
#pragma unroll
            for (int e = 0; e < 8; ++e) { o1[e] = 0.f; o2[e] = 0.f; } }
        LAS unsigned char* dst = lds + (isq ? L_Q : L_K) + r * 144;
        *(LAS v4u*)(dst + 16 * jj) = pack8(o1); *(LAS v4u*)(dst + 64 + 16 * jj) = pack8(o2);
    }
#pragma unroll
    for (int it = 0; it < 4; ++it) {
        const int id = tid + 512 * it, r = id >> 3, dc = id & 7; const int p = 128 * (n - 1) + r; float v[8];
        if (p >= 112) { const int row = row_of_tp(b, p - 112); unpack8(*(const v4u*)(PROJ + (size_t)row * NPROJ + C_SWV + kvh * 64 + 8 * dc), v);
            if (n == NSWAB - 1 && r >= 128) { float* vo = F.out + O_VP + (size_t)(((l * 2 + b) * 128 + (r - 128)) * 2 + kvh) * 64 + 8 * dc;
                *(f32x4*)vo = (f32x4){v[0], v[1], v[2], v[3]}; *(f32x4*)(vo + 4) = (f32x4){v[4], v[5], v[6], v[7]}; }
        } else {
#pragma unroll
            for (int e = 0; e < 8; ++e) v[e] = 0.f; }
#pragma unroll
        for (int e = 0; e < 8; ++e) *(LAS unsigned short*)(lds + L_VT + (8 * dc + e) * 528 + 2 * r) = (unsigned short)f2bf(v[e]);
    }
    __syncthreads();
    const int hh = wave >> 2, w4 = wave & 3, hq = 2 * kvh + hh;
    const float sink = F.in[I_SINK][l * 4 + hq];
    f32x4 sc[2][10];
#pragma unroll
    for (int rt = 0; rt < 2; ++rt) {
        bf16x8 qf[2];
#pragma unroll
        for (int kk = 0; kk < 2; ++kk) qf[kk] = *(const LAS bf16x8*)(lds + L_Q + (hh * 128 + 32 * w4 + 16 * rt + fr) * 144 + 64 * kk + 16 * fq);
#pragma unroll
        for (int kt = 0; kt < 10; ++kt) { f32x4 a = {0.f, 0.f, 0.f, 0.f};
#pragma unroll
            for (int kk = 0; kk < 2; ++kk) { const bf16x8 kf = *(const LAS bf16x8*)(lds + L_K + (16 * (2 * w4 + kt) + fr) * 144 + 64 * kk + 16 * fq); a = mma16(kf, qf[kk], a); }
            sc[rt][kt] = a; }
    }
    float linv[2];
#pragma unroll
    for (int rt = 0; rt < 2; ++rt) {
        const int i = 32 * w4 + 16 * rt + fr; float m = -1e30f;
#pragma unroll
        for (int kt = 0; kt < 10; ++kt)
#pragma unroll
            for (int r = 0; r < 4; ++r) { const int kj = 16 * (2 * w4 + kt) + 4 * fq + r, rel = i + 128 - kj; const bool ok = rel >= 0 && rel < 128 && (128 * (n - 1) + kj >= 112);
                const float s = ok ? sc[rt][kt][r] * 0.125f : -1e30f; sc[rt][kt][r] = s; m = fmaxf(m, s); }
        m = fmaxf(m, __shfl_xor(m, 16)); m = fmaxf(m, __shfl_xor(m, 32)); m = fmaxf(m, sink);
        float sum = 0.f;
#pragma unroll
        for (int kt = 0; kt < 10; ++kt)
#pragma unroll
            for (int r = 0; r < 4; ++r) { const float s = sc[rt][kt][r]; const float pv = s > -1e29f ? __expf(s - m) : 0.f; sc[rt][kt][r] = pv; sum += pv; }
        sum += __shfl_xor(sum, 16); sum += __shfl_xor(sum, 32); sum += __expf(sink - m);
        linv[rt] = 1.f / sum;
    }
    f32x4 ao[2][4];
#pragma unroll
    for (int rt = 0; rt < 2; ++rt)
#pragma unroll
        for (int dt = 0; dt < 4; ++dt) ao[rt][dt] = (f32x4){0.f, 0.f, 0.f, 0.f};
#pragma unroll
    for (int ks = 0; ks < 5; ++ks) {
        bf16x8 pf[2];
#pragma unroll
        for (int rt = 0; rt < 2; ++rt) { const v4u t = {pk2(sc[rt][2 * ks][0], sc[rt][2 * ks][1]), pk2(sc[rt][2 * ks][2], sc[rt][2 * ks][3]), pk2(sc[rt][2 * ks + 1][0], sc[rt][2 * ks + 1][1]), pk2(sc[rt][2 * ks + 1][2], sc[rt][2 * ks + 1][3])};
            pf[rt] = __builtin_bit_cast(bf16x8, t); }
#pragma unroll
        for (int dt = 0; dt < 4; ++dt) {
            const int kb = 16 * (2 * w4 + 2 * ks) + 4 * fq;
            const u32x2 v0 = *(const LAS u32x2*)(lds + L_VT + (16 * dt + fr) * 528 + 2 * kb), v1 = *(const LAS u32x2*)(lds + L_VT + (16 * dt + fr) * 528 + 2 * (kb + 16));
            const v4u t = {v0.x, v0.y, v1.x, v1.y}; const bf16x8 vf = __builtin_bit_cast(bf16x8, t);
#pragma unroll
            for (int rt = 0; rt < 2; ++rt) ao[rt][dt] = mma16(vf, pf[rt], ao[rt][dt]);
        }
    }
#pragma unroll
    for (int rt = 0; rt < 2; ++rt) { const int p = 128 * n + 32 * w4 + 16 * rt + fr;
        if (p >= 112) { bf16* o = MIXED + (size_t)row_of_tp(b, p - 112) * D + 768 + hq * 64 + 4 * fq;
#pragma unroll
            for (int dt = 0; dt < 4; ++dt) *(u32x2*)(o + 16 * dt) = pack4(ao[rt][dt][0] * linv[rt], ao[rt][dt][1] * linv[rt], ao[rt][dt][2] * linv[rt], ao[rt][dt][3] * linv[rt]); } }
    __syncthreads();
}


__device__ __forceinline__ void sdn_unit(Frame& F, int l, int sb) {
    LAS unsigned char* lds = F.lds;
    constexpr int L_CV = 0, L_OS = 49152, L_BETA = 65536, L_AT = 65664;
    int tid = F.tid; asm volatile("" : "+v"(tid)); const int lane = tid & 63, wave = __builtin_amdgcn_readfirstlane(tid >> 6);
    const bf16* PROJ = (const bf16*)(F.ws + WS_PROJ); bf16* MIXED = (bf16*)(F.ws + WS_MIXED);
    LAS float* CV = (LAS float*)(lds + L_CV); LAS float* OS = (LAS float*)(lds + L_OS); LAS float* BETA = (LAS float*)(lds + L_BETA); LAS float* AT = (LAS float*)(lds + L_AT);
    const int row0 = R_SAMPLE + sb * 8;
#pragma unroll
    for (int k = 0; k < 3; ++k) { const int ch = tid + 512 * k;
        float raw[11];
#pragma unroll
        for (int j = 0; j < 3; ++j) raw[j] = F.in[I_SDNC][((size_t)(l * DECB + sb) * 3 + j) * 1536 + ch];
#pragma unroll
        for (int t = 0; t < 8; ++t) raw[3 + t] = bf2f(PROJ[(size_t)(row0 + t) * NPROJ + ch]);
        float w[4];
#pragma unroll
        for (int i = 0; i < 4; ++i) w[i] = F.in[I_DNCW][(size_t)(l * 4 + i) * 1536 + ch];
#pragma unroll
        for (int t = 0; t < 8; ++t) CV[t * 1536 + ch] = siluf(w[0] * raw[t] + w[1] * raw[t + 1] + w[2] * raw[t + 2] + w[3] * raw[t + 3]);
#pragma unroll
        for (int j = 0; j < 3; ++j) F.out[O_DNCS + ((size_t)(l * DECB + sb) * 3 + j) * 1536 + ch] = raw[8 + j];
    }
    if (tid < 32) { const int t = tid >> 2, h = tid & 3; const float* sm = (const float*)(F.ws + WS_SMALL) + (size_t)(row0 + t) * 16;
        BETA[tid] = sigmoidf_(sm[h]); AT[tid] = __expf(-__expf(F.in[I_DNALOG][l * 4 + h]) * softplusf_(sm[4 + h] + F.in[I_DNDTB][l * 4 + h])); }
    __syncthreads();
    {
        const int t = wave;
#pragma unroll
        for (int v = 0; v < 8; ++v) { LAS float* p = CV + t * 1536 + v * 128; const float a = p[lane], b2 = p[lane + 64]; const float ss = wave_sum(a * a + b2 * b2);
            const float rn = rsqrtf(ss + EPS) * (v < 4 ? 0.08838834764831845f : 1.f); p[lane] = a * rn; p[lane + 64] = b2 * rn; }
    }
    __syncthreads();
    {
        const int h = tid >> 7, col = tid & 127;
        float S[128];
        const float* s0 = F.in[I_SDN] + ((size_t)(l * DECB + sb) * 4 + h) * 128 * 128 + col;
#pragma unroll
        for (int i0 = 0; i0 < 128; i0 += 8) {
#pragma unroll
            for (int i = 0; i < 8; ++i) S[i0 + i] = s0[i * 128];
            s0 += 8 * 128; asm volatile("" : "+v"(s0)); }
#pragma unroll 1
        for (int t = 0; t < 8; ++t) {
            const LAS float* q = CV + t * 1536 + h * 128; const LAS float* k = CV + t * 1536 + 512 + h * 128;
            const float a = AT[t * 4 + h], bt = BETA[t * 4 + h], vc = CV[t * 1536 + 1024 + h * 128 + col];
            float ks = 0.f;
#pragma unroll
            for (int i4 = 0; i4 < 32; ++i4) { const f32x4 kv = *(const LAS f32x4*)(k + 4 * i4); ks += (kv.x * S[4 * i4] + kv.y * S[4 * i4 + 1]) + (kv.z * S[4 * i4 + 2] + kv.w * S[4 * i4 + 3]);
                if ((i4 & 3) == 3) asm volatile("" : "+v"(ks) :: "memory"); }
            const float coef = bt * (vc - a * ks); float o = 0.f;
#pragma unroll
            for (int i4 = 0; i4 < 32; ++i4) { const f32x4 kv = *(const LAS f32x4*)(k + 4 * i4); const f32x4 qv = *(const LAS f32x4*)(q + 4 * i4);
                S[4 * i4] = a * S[4 * i4] + coef * kv.x; S[4 * i4 + 1] = a * S[4 * i4 + 1] + coef * kv.y; S[4 * i4 + 2] = a * S[4 * i4 + 2] + coef * kv.z; S[4 * i4 + 3] = a * S[4 * i4 + 3] + coef * kv.w;
                o += (qv.x * S[4 * i4] + qv.y * S[4 * i4 + 1]) + (qv.z * S[4 * i4 + 2] + qv.w * S[4 * i4 + 3]);
                if ((i4 & 3) == 3) asm volatile("" : "+v"(o) :: "memory"); }
            OS[t * 512 + tid] = o;
        }
        float* so = F.out + O_DNS + ((size_t)(l * DECB + sb) * 4 + h) * 128 * 128 + col;
#pragma unroll
        for (int i0 = 0; i0 < 128; i0 += 8) {
#pragma unroll
            for (int i = 0; i < 8; ++i) so[i * 128] = S[i0 + i];
            so += 8 * 128; asm volatile("" : "+v"(so)); }
    }
    __syncthreads();
    {
        const int t = wave, row = row0 + t;
#pragma unroll
        for (int h = 0; h < 4; ++h) { const float a = OS[t * 512 + h * 128 + lane], b2 = OS[t * 512 + h * 128 + lane + 64]; const float rn = rsqrtf(wave_sum(a * a + b2 * b2) * (1.f / 128.f) + EPS);
            const float z0 = bf2f(PROJ[(size_t)row * NPROJ + C_DNZ + h * 128 + lane]), z1 = bf2f(PROJ[(size_t)row * NPROJ + C_DNZ + h * 128 + lane + 64]);
            MIXED[(size_t)row * D + h * 128 + lane] = (bf16)f2bf(a * rn * F.in[I_DNNW][l * 128 + lane] * siluf(z0));
            MIXED[(size_t)row * D + h * 128 + lane + 64] = (bf16)f2bf(b2 * rn * F.in[I_DNNW][l * 128 + lane + 64] * siluf(z1)); }
    }
    __syncthreads();
}
__device__ __forceinline__ void sssm_unit(Frame& F, int l, int sb) {
    LAS unsigned char* lds = F.lds;
    constexpr int L_CX = 0, L_YS = 24576, L_DT = 32768, L_DA = 32896;
    int tid = F.tid; asm volatile("" : "+v"(tid)); const int lane = tid & 63, wave = __builtin_amdgcn_readfirstlane(tid >> 6);
    const bf16* PROJ = (const bf16*)(F.ws + WS_PROJ); bf16* MIXED = (bf16*)(F.ws + WS_MIXED);
    LAS float* CX = (LAS float*)(lds + L_CX); LAS float* YS = (LAS float*)(lds + L_YS); LAS float* DTs = (LAS float*)(lds + L_DT); LAS float* DA = (LAS float*)(lds + L_DA);
    const int row0 = R_SAMPLE + sb * 8;
#pragma unroll
    for (int k = 0; k < 2; ++k) { const int ch = tid + 512 * k;
        if (ch < 768) {
            float raw[11];
#pragma unroll
            for (int j = 0; j < 3; ++j) raw[j] = F.in[I_SSSMC][((size_t)(l * DECB + sb) * 3 + j) * 768 + ch];
#pragma unroll
            for (int t = 0; t < 8; ++t) raw[3 + t] = bf2f(PROJ[(size_t)(row0 + t) * NPROJ + C_SSX + ch]);
            float w[4];
#pragma unroll
            for (int i = 0; i < 4; ++i) w[i] = F.in[I_SSCW][(size_t)(l * 4 + i) * 768 + ch];
            const float bias = F.in[I_SSCB][l * 768 + ch];
#pragma unroll
            for (int t = 0; t < 8; ++t) CX[t * 768 + ch] = siluf(bias + w[0] * raw[t] + w[1] * raw[t + 1] + w[2] * raw[t + 2] + w[3] * raw[t + 3]);
#pragma unroll
            for (int j = 0; j < 3; ++j) F.out[O_SSMCS + ((size_t)(l * DECB + sb) * 3 + j) * 768 + ch] = raw[8 + j];
        }
    }
    if (tid < 32) { const int t = tid >> 2, h = tid & 3; const float dt = softplusf_(((const float*)(F.ws + WS_SMALL))[(size_t)(row0 + t) * 16 + 8 + h] + F.in[I_SSDTB][l * 4 + h]);
        DTs[tid] = dt; DA[tid] = __expf(-__expf(F.in[I_SSALOG][l * 4 + h]) * dt); }
    __syncthreads();
    {
        const int h = tid >> 7, t128 = tid & 127, pq = t128 >> 5, s4 = t128 & 31, g = h >> 1;
        f32x4 hr[16];
        const float* h0 = F.in[I_SSSM] + ((size_t)(l * DECB + sb) * 4 + h) * 64 * 128 + (size_t)(pq * 16) * 128 + 4 * s4;
#pragma unroll
        for (int jj = 0; jj < 16; ++jj) hr[jj] = *(const f32x4*)(h0 + (size_t)jj * 128);
#pragma unroll 1
        for (int t = 0; t < 8; ++t) {
            const float da = DA[t * 4 + h], dtv = DTs[t * 4 + h];
            const f32x4 B4 = *(const LAS f32x4*)(CX + t * 768 + 256 + g * 128 + 4 * s4), C4 = *(const LAS f32x4*)(CX + t * 768 + 512 + g * 128 + 4 * s4);
#pragma unroll
            for (int jj = 0; jj < 16; ++jj) { const float xv = CX[t * 768 + h * 64 + pq * 16 + jj] * dtv;
                hr[jj] = hr[jj] * da + B4 * xv;
                float part = (hr[jj].x * C4.x + hr[jj].y * C4.y) + (hr[jj].z * C4.z + hr[jj].w * C4.w);
                part += __shfl_xor(part, 1); part += __shfl_xor(part, 2); part += __shfl_xor(part, 4); part += __shfl_xor(part, 8); part += __shfl_xor(part, 16);
                if (s4 == 0) YS[t * 256 + h * 64 + pq * 16 + jj] = part; }
        }
        float* ho = F.out + O_SSMS + ((size_t)(l * DECB + sb) * 4 + h) * 64 * 128 + (size_t)(pq * 16) * 128 + 4 * s4;
#pragma unroll
        for (int jj = 0; jj < 16; ++jj) *(f32x4*)(ho + (size_t)jj * 128) = hr[jj];
    }
    __syncthreads();
    {
        const int t = wave, row = row0 + t;
#pragma unroll
        for (int g = 0; g < 2; ++g) { float v[2];
#pragma unroll
            for (int e = 0; e < 2; ++e) { const int idx = g * 128 + lane + 64 * e, h = idx >> 6; const float z = bf2f(PROJ[(size_t)row * NPROJ + C_SSZ + idx]);
                v[e] = (YS[t * 256 + idx] + CX[t * 768 + idx] * F.in[I_SSD][l * 4 + h]) * siluf(z); }
            const float rn = rsqrtf(wave_sum(v[0] * v[0] + v[1] * v[1]) * (1.f / 128.f) + EPS);
#pragma unroll
            for (int e = 0; e < 2; ++e) { const int idx = g * 128 + lane + 64 * e; MIXED[(size_t)row * D + 512 + idx] = (bf16)f2bf(v[e] * rn * F.in[I_SSNW][l * 256 + idx]); } }
    }
    __syncthreads();
}
__device__ __forceinline__ void sswa_unit(Frame& F, int l, int sb) {
    LAS unsigned char* lds = F.lds;
    constexpr int L_KC = 0, L_VC = 39168, L_QS = 78336, L_SC = 86528;
    int tid = F.tid; asm volatile("" : "+v"(tid)); const int lane = tid & 63, wave = __builtin_amdgcn_readfirstlane(tid >> 6);
    const bf16* PROJ = (const bf16*)(F.ws + WS_PROJ); bf16* MIXED = (bf16*)(F.ws + WS_MIXED);
    LAS float* QS = (LAS float*)(lds + L_QS); LAS float* SC = (LAS float*)(lds + L_SC);
    const int row0 = R_SAMPLE + sb * 8;
    const float* kc = F.in[I_CK] + (size_t)(l * DECB + sb) * 128 * 128; const float* vc = F.in[I_CV] + (size_t)(l * DECB + sb) * 128 * 128;
    float* kso = F.out + O_KS + (size_t)(l * DECB + sb) * 128 * 128; float* vso = F.out + O_VS + (size_t)(l * DECB + sb) * 128 * 128;
#pragma unroll
    for (int it = 0; it < 8; ++it) { const int idx4 = tid + 512 * it, rowk = idx4 >> 4, c4 = idx4 & 15;
        const f32x4 kv = *(const f32x4*)(kc + (size_t)idx4 * 4), vv = *(const f32x4*)(vc + (size_t)idx4 * 4);
        *(LAS u32x2*)(lds + L_KC + rowk * 144 + c4 * 8) = pack4(kv.x, kv.y, kv.z, kv.w); *(LAS u32x2*)(lds + L_VC + rowk * 144 + c4 * 8) = pack4(vv.x, vv.y, vv.z, vv.w);
        if (rowk >= 16) { *(f32x4*)(kso + (size_t)(idx4 - 256) * 4) = kv; *(f32x4*)(vso + (size_t)(idx4 - 256) * 4) = vv; } }
    {
        const int t = tid >> 6, kvh = (tid >> 5) & 1, j = tid & 31; const bf16* pr = PROJ + (size_t)(row0 + t) * NPROJ;
        const float x1 = bf2f(pr[C_SWK + kvh * 64 + j]), x2 = bf2f(pr[C_SWK + kvh * 64 + 32 + j]);
        float sn, cs; sincosf((float)(SEQ + t) * rope_inv(j), &sn, &cs);
        const float o1 = x1 * cs - x2 * sn, o2 = x2 * cs + x1 * sn; const int rowk = (128 + t) * 2 + kvh;
        *(LAS unsigned short*)(lds + L_KC + rowk * 144 + 2 * j) = (unsigned short)f2bf(o1); *(LAS unsigned short*)(lds + L_KC + rowk * 144 + 2 * (j + 32)) = (unsigned short)f2bf(o2);
        kso[(size_t)((120 + t) * 2 + kvh) * 64 + j] = o1; kso[(size_t)((120 + t) * 2 + kvh) * 64 + 32 + j] = o2;
#pragma unroll
        for (int e = 0; e < 2; ++e) { const int d = j + 32 * e; const float v = bf2f(pr[C_SWV + kvh * 64 + d]);
            *(LAS unsigned short*)(lds + L_VC + rowk * 144 + 2 * d) = (unsigned short)f2bf(v); vso[(size_t)((120 + t) * 2 + kvh) * 64 + d] = v; }
#pragma unroll
        for (int e = 0; e < 2; ++e) { const int hq = 2 * kvh + e;
            const float q1 = bf2f(pr[C_SWQ + hq * 64 + j]), q2 = bf2f(pr[C_SWQ + hq * 64 + 32 + j]);
            QS[(t * 4 + hq) * 64 + j] = q1 * cs - q2 * sn; QS[(t * 4 + hq) * 64 + 32 + j] = q2 * cs + q1 * sn; }
    }
    __syncthreads();
    if (tid < 272) {
        const int key = tid >> 1, kvh = tid & 1; float acc[16];
#pragma unroll
        for (int i = 0; i < 16; ++i) acc[i] = 0.f;
#pragma unroll
        for (int dc = 0; dc < 8; ++dc) { float kv[8]; unpack8(*(const LAS v4u*)(lds + L_KC + tid * 144 + dc * 16), kv);
#pragma unroll
            for (int t = 0; t < 8; ++t)
#pragma unroll
                for (int hh = 0; hh < 2; ++hh) { const LAS float* q = QS + (t * 4 + 2 * kvh + hh) * 64 + 8 * dc; const f32x4 qa = *(const LAS f32x4*)q, qb = *(const LAS f32x4*)(q + 4);
                    acc[t * 2 + hh] += (kv[0] * qa.x + kv[1] * qa.y) + (kv[2] * qa.z + kv[3] * qa.w) + (kv[4] * qb.x + kv[5] * qb.y) + (kv[6] * qb.z + kv[7] * qb.w); } }
#pragma unroll
        for (int t = 0; t < 8; ++t)
#pragma unroll
            for (int hh = 0; hh < 2; ++hh) SC[(t * 4 + 2 * kvh + hh) * 140 + key] = acc[t * 2 + hh] * 0.125f;
    }
    __syncthreads();
#pragma unroll
    for (int rr = 0; rr < 4; ++rr) { const int r = 4 * wave + rr, t = r >> 2, hq = r & 3; const float sink = F.in[I_SINK][l * 4 + hq];
        float s[3]; float m = -1e30f;
#pragma unroll
        for (int e = 0; e < 3; ++e) { const int key = lane + 64 * e; const bool ok = key < 136 && key >= t + 1 && key <= t + 128; s[e] = ok ? SC[r * 140 + key] : -1e30f; m = fmaxf(m, s[e]); }
        m = fmaxf(wave_max(m), sink); float sum = 0.f;
#pragma unroll
        for (int e = 0; e < 3; ++e) { s[e] = s[e] > -1e29f ? __expf(s[e] - m) : 0.f; sum += s[e]; }
        sum = wave_sum(sum) + __expf(sink - m); const float inv = 1.f / sum;
#pragma unroll
        for (int e = 0; e < 3; ++e) { const int key = lane + 64 * e; if (key < 136) SC[r * 140 + key] = s[e] * inv; } }
    __syncthreads();
    {
        const int r = tid >> 4, dq = tid & 15, t = r >> 2, hq = r & 3, kvh = hq >> 1; float o[4] = {0.f, 0.f, 0.f, 0.f};
        for (int key = 0; key < 136; ++key) { const float p = SC[r * 140 + key]; const u32x2 v = *(const LAS u32x2*)(lds + L_VC + (key * 2 + kvh) * 144 + dq * 8);
            o[0] += p * bflo(v.x); o[1] += p * bfhi(v.x); o[2] += p * bflo(v.y); o[3] += p * bfhi(v.y); }
        *(u32x2*)(MIXED + (size_t)(row0 + t) * D + 768 + hq * 64 + 4 * dq) = pack4(o[0], o[1], o[2], o[3]);
    }
    __syncthreads();
}
__device__ __forceinline__ void phase_m2(Frame& F, int l) {
    const int xg = F.vcu >> 5, xi = F.vcu & 31;
    if (xi < 4) dn_scan(F, l, xg >> 2, xg & 3, xi);
    else if (xi == 4) ssm_scan(F, l, xg >> 2, xg & 3);
    else {
        const int widx = xg * 27 + (xi - 5); constexpr int NW = 216, NSWA = 2 * NSWAB * 2;
        for (int u = widx; u < DECB + NSWA + DECB + DECB; u += NW) {
            if (u < DECB) sdn_unit(F, l, u);
            else if (u < DECB + NSWA) { const int v = u - DECB, b = v / (NSWAB * 2), rem = v % (NSWAB * 2); swa_unit(F, l, b, rem >> 1, rem & 1); }
            else if (u < DECB + NSWA + DECB) sssm_unit(F, l, u - DECB - NSWA);
            else sswa_unit(F, l, u - DECB - NSWA - DECB);
        }
    }
}
__device__ __forceinline__ void phase_m3(Frame& F, int l) {
    const int gw = F.vcu * NWAVES + F.wave, NGW = F.G * NWAVES, lane = F.lane;
    const bf16* PROJ = (const bf16*)(F.ws + WS_PROJ); bf16* MIXED = (bf16*)(F.ws + WS_MIXED);
    for (int k = gw; k < R_SAMPLE + 32; k += NGW) {
        const int row = k < R_SAMPLE ? k : R_META + (k - R_SAMPLE);
        {   float o[8], z[8]; unpack8(*(const v4u*)(MIXED + (size_t)row * D + 8 * lane), o); unpack8(*(const v4u*)(PROJ + (size_t)row * NPROJ + C_DNZ + 8 * lane), z);
            float ss = 0.f;
#pragma unroll
            for (int e = 0; e < 8; ++e) ss += o[e] * o[e];
            ss += __shfl_xor(ss, 1); ss += __shfl_xor(ss, 2); ss += __shfl_xor(ss, 4); ss += __shfl_xor(ss, 8);
            const float rn = rsqrtf(ss * (1.f / 128.f) + EPS); const float* w = F.in[I_DNNW] + l * 128 + ((8 * lane) & 127);
#pragma unroll
            for (int e = 0; e < 8; ++e) o[e] = o[e] * rn * w[e] * siluf(z[e]);
            *(v4u*)(MIXED + (size_t)row * D + 8 * lane) = pack8(o); }
        {   const u32x2 yr = *(const u32x2*)(MIXED + (size_t)row * D + 512 + 4 * lane), zr = *(const u32x2*)(PROJ + (size_t)row * NPROJ + C_SSZ + 4 * lane);
            float y[4] = {bflo(yr.x) * siluf(bflo(zr.x)), bfhi(yr.x) * siluf(bfhi(zr.x)), bflo(yr.y) * siluf(bflo(zr.y)), bfhi(yr.y) * siluf(bfhi(zr.y))};
            float ss = (y[0] * y[0] + y[1] * y[1]) + (y[2] * y[2] + y[3] * y[3]);
            ss += __shfl_xor(ss, 1); ss += __shfl_xor(ss, 2); ss += __shfl_xor(ss, 4); ss += __shfl_xor(ss, 8); ss += __shfl_xor(ss, 16);
            const float rn = rsqrtf(ss * (1.f / 128.f) + EPS); const float* w = F.in[I_SSNW] + l * 256 + 4 * lane;
            *(u32x2*)(MIXED + (size_t)row * D + 512 + 4 * lane) = pack4(y[0] * rn * w[0], y[1] * rn * w[1], y[2] * rn * w[2], y[3] * rn * w[3]); }
    }
    convert_weight(F, 1, l, gw, NGW); convert_weight(F, 2, l, gw, NGW); convert_weight(F, 3, l, gw, NGW);
    if (l == 0) convert_weight(F, 0, 1, gw, NGW);
    __syncthreads();
}

constexpr int N_PHASES = 19;
__global__ void __launch_bounds__(NTHREADS, 2) hybrid_fwd(Args args) {
    extern __shared__ __attribute__((aligned(16))) unsigned char lds_raw[];
    Frame F;
    F.lds = (LAS unsigned char*)lds_raw;
    F.tid = threadIdx.x; F.lane = F.tid & 63; F.wave = __builtin_amdgcn_readfirstlane(F.tid >> 6);
    const int wave0 = F.wave;
    F.G = gridDim.x; { const int bx = blockIdx.x; F.vcu = (F.G % 8 == 0) ? (bx % 8) * (F.G / 8) + bx / 8 : bx; }
    const int vcu0 = F.vcu;
    { KaPtr ka_ = (KaPtr)__builtin_amdgcn_kernarg_segment_ptr(); F.in.ka = ka_; F.out = ka_->out; F.ws = ka_->ws; }
    gu32* ctl = (gu32*)(F.ws + WS_CTL);
    for (int u = F.tid; u < (LDS_BYTES - LDSCTL_OFF) / 4; u += NTHREADS) ((LAS unsigned*)(F.lds + LDSCTL_OFF))[u] = 0u;
    __syncthreads();
    const int lo = args.ph_lo, hi = args.ph_hi;
    const bool multi = (hi - lo) > 1;
    XcdBarrier bar; bar.bar = (unsigned*)(ctl + CW_BAR); bar.x = 0; bar.st = nullptr;
    if (multi) bar = xcd_barrier_post((unsigned*)(ctl + CW_BAR), (volatile LAS unsigned*)(F.lds + LDSCTL_OFF + 32), F.tid);
    int bx_ = 0;
#define PH_BEGIN(phidx) if (lo <= (phidx) && (phidx) < hi) { \
        { KaPtr ka_ = (KaPtr)__builtin_amdgcn_kernarg_segment_ptr(); int tid_ = (wave0 << 6) | (int)__builtin_amdgcn_mbcnt_hi(~0u, __builtin_amdgcn_mbcnt_lo(~0u, 0u)), vcu_ = vcu0, G_ = gridDim.x; bx_ = blockIdx.x; LAS unsigned char* lds_ = (LAS unsigned char*)lds_raw; \
          asm volatile("" : "+s"(ka_), "+v"(tid_), "+s"(vcu_), "+s"(G_), "+v"(lds_), "+s"(bx_)); \
          F.in.ka = ka_; F.out = ka_->out; F.ws = ka_->ws; F.tid = tid_; F.lane = tid_ & 63; F.wave = __builtin_amdgcn_readfirstlane(tid_ >> 6); F.vcu = vcu_; F.G = G_; F.lds = lds_; } \
        bf16* WIN = (bf16*)(F.ws + WS_WIN); bf16* WOUT = (bf16*)(F.ws + WS_WOUT); bf16* WFI = (bf16*)(F.ws + WS_WFI); bf16* WFO = (bf16*)(F.ws + WS_WFO); \
        bf16* XN = (bf16*)(F.ws + WS_XN); bf16* PROJ = (bf16*)(F.ws + WS_PROJ); bf16* MIXED = (bf16*)(F.ws + WS_MIXED); bf16* MOUT = (bf16*)(F.ws + WS_MOUT); bf16* ACT = (bf16*)(F.ws + WS_PROJ); \
        (void)WIN; (void)WOUT; (void)WFI; (void)WFO; (void)XN; (void)PROJ; (void)MIXED; (void)MOUT; (void)ACT;
#define PH_END(phidx) if ((phidx) + 1 < hi) { XcdBarrier b2 = bar; unsigned* bp_ = b2.bar; unsigned bxx_ = b2.x; asm volatile("" : "+s"(bp_), "+s"(bxx_)); b2.bar = bp_; b2.x = bxx_; xcd_barrier(b2, F.tid); } }
#define GEMM_BF16(Aop, Bop, Oop, Nn, Kk) do { pg8::Gemm g{Aop, Bop, MPAD, Nn, Kk}; pg8::StaticOrder S; S.init(MPAD, Nn, F.G, bx_); pg8::EpiBf16<0> E{Oop, Nn, nullptr, 0, 0, 1.f}; \
        pg8::gemm_phase<pg8::EpiBf16<0>, pg8::StaticOrder, true, true>(F.lds, g, S, E, F.tid); } while (0)
#define GEMM_SWIGLU() do { pg8::Gemm g{XN, WFI, MPAD, NFF2, D}; pg8::StaticOrder S; S.init(MPAD, NFF2, F.G, bx_); pg8::EpiSwiGLU E{ACT, DFF}; \
        pg8::gemm_phase<pg8::EpiSwiGLU, pg8::StaticOrder, true, true>(F.lds, g, S, E, F.tid); } while (0)
#define LAYER(l) \
    PH_BEGIN(1 + 9 * (l) + 0) GEMM_BF16(XN, WIN, PROJ, NPROJ, D); PH_END(1 + 9 * (l) + 0) \
    PH_BEGIN(1 + 9 * (l) + 1) phase_m1(F, (l)); PH_END(1 + 9 * (l) + 1) \
    PH_BEGIN(1 + 9 * (l) + 2) phase_m2(F, (l)); PH_END(1 + 9 * (l) + 2) \
    PH_BEGIN(1 + 9 * (l) + 3) phase_m3(F, (l)); PH_END(1 + 9 * (l) + 3) \
    PH_BEGIN(1 + 9 * (l) + 4) GEMM_BF16(MIXED, WOUT, MOUT, D, D); PH_END(1 + 9 * (l) + 4) \
    PH_BEGIN(1 + 9 * (l) + 5) phase_norm<1>(F, (l)); PH_END(1 + 9 * (l) + 5) \
    PH_BEGIN(1 + 9 * (l) + 6) GEMM_SWIGLU(); PH_END(1 + 9 * (l) + 6) \
    PH_BEGIN(1 + 9 * (l) + 7) GEMM_BF16(ACT, WFO, MOUT, D, DFF); PH_END(1 + 9 * (l) + 7) \
    PH_BEGIN(1 + 9 * (l) + 8) phase_norm<2>(F, (l)); PH_END(1 + 9 * (l) + 8)
    PH_BEGIN(0) convert_weight(F, 0, 0, F.vcu * NWAVES + F.wave, F.G * NWAVES); phase_norm<0>(F, 0); PH_END(0)
    LAYER(0)
    LAYER(1)
}

#ifndef MK_ONE_LAUNCH
#define MK_ONE_LAUNCH 1
#endif
extern "C" void kernel_launch(void* const* d_in, const int* in_sizes, int n_in, void* d_out, int out_size, void* d_ws, size_t ws_size, hipStream_t stream) {
    static int grid = 0;
    if (grid == 0) {
        if (n_in != N_IN || (size_t)out_size != O_END || ws_size < WS_END) { fprintf(stderr, "kernel_launch: unexpected shapes: n_in %d out %d ws %zu (need %zu)\n", n_in, out_size, ws_size, (size_t)WS_END); grid = -1; return; }
        int dev = 0, cus = 0, per_cu = 0;
        if (hipGetDevice(&dev) != hipSuccess || hipDeviceGetAttribute(&cus, hipDeviceAttributeMultiprocessorCount, dev) != hipSuccess) { grid = -1; return; }
        if (hipFuncSetAttribute((const void*)hybrid_fwd, hipFuncAttributeMaxDynamicSharedMemorySize, LDS_BYTES) != hipSuccess) { fprintf(stderr, "kernel_launch: hipFuncSetAttribute failed\n"); grid = -1; return; }
        if (hipOccupancyMaxActiveBlocksPerMultiprocessor(&per_cu, (const void*)hybrid_fwd, NTHREADS, LDS_BYTES) != hipSuccess || per_cu < 1) fprintf(stderr, "kernel_launch: occupancy query says %d\n", per_cu);
        (void)hipGetLastError();
        grid = cus;
        if (grid != 256) { fprintf(stderr, "kernel_launch: built for a 256-CU device, got %d\n", cus); grid = -1; return; }
    }
    if (grid < 0) return;
    (void)hipMemsetAsync((char*)d_ws + WS_CTL, 0, CTL_ZERO_BYTES, stream);
    Args a{};
    for (int i = 0; i < N_IN; ++i) a.in[i] = (const float*)d_in[i];
    a.out = (float*)d_out; a.ws = (unsigned char*)d_ws;
#if MK_ONE_LAUNCH
    a.ph_lo = 0; a.ph_hi = N_PHASES;
    hipLaunchKernelGGL(hybrid_fwd, dim3(grid), dim3(NTHREADS), LDS_BYTES, stream, a);
#else
    for (int ph = 0; ph < N_PHASES; ++ph) { a.ph_lo = ph; a.ph_hi = ph + 1; hipLaunchKernelGGL(hybrid_fwd, dim3(grid), dim3(NTHREADS), LDS_BYTES, stream, a); }
#endif
}
```

```cpp
#include <hip/hip_runtime.h>
#include <cstdio>
#include <cstdint>

namespace pg8 {
#define PG8_LAS __attribute__((address_space(3)))
typedef unsigned short bf16_t;
typedef short bf16x8 __attribute__((ext_vector_type(8)));
typedef float f32x4 __attribute__((ext_vector_type(4)));
typedef unsigned u32x4 __attribute__((ext_vector_type(4)));
constexpr int BM = 256, BK = 64, HALF = 128, HTB = HALF * BK * 2  , STAGE_BYTES = 8 * HTB, NXCD = 8, WGM = 8;

__host__ __device__ __forceinline__ int lds_byte(int r, int c) { const int st = (r >> 4) * 2 + (c >> 5), rr = r & 15, cc = c & 31, ob = rr * 64 + cc * 2; return st * 1024 + (ob ^ (((ob >> 9) & 1) << 5)); }
__host__ __device__ __forceinline__ void stage_rc(int b, int& R, int& C) { const int st = b / 1024, sb = b % 1024, swz = sb ^ (((sb >> 9) & 1) << 5); R = (st >> 1) * 16 + swz / 64; C = (st & 1) * 32 + (swz % 64) / 2; }
__host__ __device__ __forceinline__ int perm32(int rho) { const int n = rho >> 4, i = rho & 15; return 8 * (i >> 2) + 4 * n + (i & 3); }

struct Unit { int pm, pn, kofs; };
struct Gemm { const bf16_t* A; const bf16_t* Bt; int M, N, K, ld; };

struct StaticOrder {
    int nM, nN, nwg, G, c;
    __host__ __device__ void init(int M, int N, int G_, int c_) { nM = M / BM; nN = N / BM; nwg = nM * nN; G = G_; c = c_; }
    __host__ __device__ bool next(int i, Unit& u) const {
        const long L = (long)i * G + c; if (L >= nwg) return false;
        int wgid = (int)L; { const int q = nwg / NXCD, r = nwg % NXCD, xcd = wgid % NXCD, off = wgid / NXCD; wgid = (xcd < r ? xcd * (q + 1) : r * (q + 1) + (xcd - r) * q) + off; }
        const int nig = WGM * nN, gid = wgid / nig, fm = gid * WGM, gsz = (nM - fm) < WGM ? (nM - fm) : WGM;
        u.pm = fm + ((wgid % nig) % gsz); u.pn = (wgid % nig) / gsz; u.kofs = 0; return true;
    }
    __device__ __forceinline__ void a_ready(const Unit&) const {}
    __device__ __forceinline__ void done(const Unit&) const {}
};

__device__ __forceinline__ unsigned cvt_pk_bf16(float lo, float hi) { unsigned r; asm volatile("v_cvt_pk_bf16_f32 %0, %1, %2" : "=v"(r) : "v"(lo), "v"(hi)); return r; }
typedef float f32x2 __attribute__((ext_vector_type(2)));
__device__ __forceinline__ f32x2 gelu_pk(f32x2 v) {
    const f32x2 av = __builtin_elementwise_abs(v), d = av * 0.2316418882f + 1.0f;
    f32x2 t; t.x = __builtin_amdgcn_rcpf(d.x); t.y = __builtin_amdgcn_rcpf(d.y);
    f32x2 q = t * 0.5307027145f + (-0.7265760135f); q = q * t + 0.7107068705f; q = q * t + (-0.142248368f); q = q * t + 0.127414796f; q = q * t;
    const f32x2 s = (v * v) * (-0.72134752044f);
    f32x2 e; e.x = __builtin_amdgcn_exp2f(s.x); e.y = __builtin_amdgcn_exp2f(s.y);
    const f32x2 m = v * (q * e), r = v - m;
    f32x2 o; o.x = v.x < 0.f ? m.x : r.x; o.y = v.y < 0.f ? m.y : r.y; return o;
}

template <int ACT  > struct EpiBf16 {
    static constexpr bool PERM = true, AFTER_DRAIN = false; static_assert(ACT == 0 || ACT == 1, "EpiBf16: ACT is 0 (none) or 1 (gelu_pk)");
    bf16_t* O; int ldc; const float* bias; int split_cols; size_t split_stride; float scale0;
    __device__ __forceinline__ void operator()(const f32x4 (&acc)[2][2][4][2], const Unit& u, int wr, int wc, int fr, int fq) const {
        const int row0 = u.pm * BM + wr * 64 + fr; int colt = u.pn * BM; bf16_t* base = O;
        float sc = 1.f; if (split_cols) { const int t = colt / split_cols; base += (size_t)t * split_stride; colt -= t * split_cols; if (t == 0) sc = scale0; }
        const int col0 = colt + wc * 32 + 8 * fq, bcol0 = u.pn * BM + wc * 32 + 8 * fq;
        f32x4 bv[2][2];
#pragma unroll
        for (int bj = 0; bj < 2; ++bj)
#pragma unroll
            for (int n = 0; n < 2; ++n) bv[bj][n] = bias ? *(const f32x4*)(bias + bcol0 + bj * HALF + 4 * n) : (f32x4){0.f, 0.f, 0.f, 0.f};
#pragma unroll
        for (int ai = 0; ai < 2; ++ai)
#pragma unroll
            for (int m = 0; m < 4; ++m) { bf16_t* rowp = base + (size_t)(row0 + ai * HALF + m * 16) * ldc + col0;
#pragma unroll
                for (int bj = 0; bj < 2; ++bj) { f32x4 v0 = acc[ai][bj][m][0] + bv[bj][0], v1 = acc[ai][bj][m][1] + bv[bj][1];
                    if (ACT == 1) { f32x2 a = gelu_pk((f32x2){v0[0], v0[1]}), b = gelu_pk((f32x2){v0[2], v0[3]}), c = gelu_pk((f32x2){v1[0], v1[1]}), d = gelu_pk((f32x2){v1[2], v1[3]});
                        v0 = (f32x4){a.x, a.y, b.x, b.y}; v1 = (f32x4){c.x, c.y, d.x, d.y}; }
                    v0 = v0 * sc; v1 = v1 * sc; u32x4 w; w.x = cvt_pk_bf16(v0[0], v0[1]); w.y = cvt_pk_bf16(v0[2], v0[3]); w.z = cvt_pk_bf16(v1[0], v1[1]); w.w = cvt_pk_bf16(v1[2], v1[3]);
                    *(u32x4*)(rowp + bj * HALF) = w; } }
    }
};

struct EpiSwiGLU {
    static constexpr bool PERM = true, AFTER_DRAIN = false;
    bf16_t* O; int ldc;
    __device__ __forceinline__ void operator()(const f32x4 (&acc)[2][2][4][2], const Unit& u, int wr, int wc, int fr, int fq) const {
        const int row0 = u.pm * BM + wr * 64 + fr; const int col0 = u.pn * HALF + wc * 32 + 8 * fq;
#pragma unroll
        for (int ai = 0; ai < 2; ++ai)
#pragma unroll
            for (int m = 0; m < 4; ++m) { bf16_t* rowp = O + (size_t)(row0 + ai * HALF + m * 16) * ldc + col0;
                float v[8];
#pragma unroll
                for (int n = 0; n < 2; ++n)
#pragma unroll
                    for (int e = 0; e < 4; ++e) { const float g = acc[ai][0][m][n][e], up = acc[ai][1][m][n][e]; v[n * 4 + e] = g * __builtin_amdgcn_rcpf(1.f + __expf(-g)) * up; }
                u32x4 w; w.x = cvt_pk_bf16(v[0], v[1]); w.y = cvt_pk_bf16(v[2], v[3]); w.z = cvt_pk_bf16(v[4], v[5]); w.w = cvt_pk_bf16(v[6], v[7]);
                *(u32x4*)rowp = w; }
    }
};

struct TailOrder {
    int nsub, S, kslice, G, c;
    __host__ __device__ void init(int S_, int kslice_, int G_, int c_) { S = S_; kslice = kslice_; nsub = 20 * S_; G = G_; c = c_; }
    __host__ __device__ bool next(int i, Unit& u) const { const int L = i * G + c; if (L >= nsub) return false; const int t = L / S, ks = L % S; u.pm = 64 + (t >> 2); u.pn = t & 3; u.kofs = ks * kslice; return true; }
    __device__ __forceinline__ void a_ready(const Unit&) const {}
    __device__ __forceinline__ void done(const Unit&) const {}
};
struct EpiPartF32 {
    static constexpr bool PERM = false, AFTER_DRAIN = false;
    float* P; int kslice;
    __device__ __forceinline__ void operator()(const f32x4 (&acc)[2][2][4][2], const Unit& u, int wr, int wc, int fr, int fq) const {
        float* base = P + (size_t)(u.kofs / kslice) * 1280 * 1024 + (size_t)((u.pm - 64) * BM + wr * 64 + fr) * 1024 + u.pn * BM + wc * 32 + 4 * fq;
#pragma unroll
        for (int ai = 0; ai < 2; ++ai)
#pragma unroll
            for (int m = 0; m < 4; ++m)
#pragma unroll
                for (int bj = 0; bj < 2; ++bj)
#pragma unroll
                    for (int n = 0; n < 2; ++n) *(f32x4*)(base + (size_t)(ai * HALF + m * 16) * 1024 + bj * HALF + n * 16) = acc[ai][bj][m][n];
    }
};

template <class Epi, class Sched, bool ALIGN_EPI = false, bool SP2 = false>
__device__ __forceinline__ void gemm_phase(PG8_LAS unsigned char* lds, const Gemm g, const Sched& S, const Epi& E, const int tid_in) {
    const int tid = tid_in, wid = __builtin_amdgcn_readfirstlane(tid >> 6), lane = tid & 63, wr = wid >> 2, wc = wid & 3, fr = lane & 15, fq = lane >> 4;
    const int K = g.ld, nt = g.K / BK;
    unsigned voffA[2], voffB[2];
#pragma unroll
    for (int i = 0; i < 2; ++i) { int R, C; stage_rc(tid * 16 + i * 8192, R, C); const int Rb = Epi::PERM ? ((R & ~31) + perm32(R & 31)) : R;
        voffA[i] = (unsigned)(R * K + C) * 2u; voffB[i] = (unsigned)(Rb * K + C) * 2u; }
    const size_t kstep = (size_t)(BK * 2);
    const size_t hstep = (size_t)HALF * K * 2;
    const size_t tstep = 2 * hstep;
    const unsigned ldsw = (unsigned)wid * 1024u;
    const int aoff = lds_byte(wr * 64 + fr, fq * 8), boff = lds_byte(wc * 32 + fr, fq * 8);
#define PG8_SA(b, h) (((b) * 2 + (h)) * HTB)
#define PG8_SB(b, h) ((4 + (b) * 2 + (h)) * HTB)
#define PG8_STAGE(bufoff, gbase, voff) do { _Pragma("unroll") for (int _i = 0; _i < 2; ++_i) \
        __builtin_amdgcn_global_load_lds((const unsigned*)((const char*)(gbase) + (voff)[_i]), (PG8_LAS unsigned*)(lds + (bufoff) + ldsw + _i * 8192), 16, 0, 0); } while (0)
#define PG8_LDA(dst, b, h) do { _Pragma("unroll") for (int m = 0; m < 4; ++m) _Pragma("unroll") for (int k = 0; k < 2; ++k) dst[m][k] = *(const PG8_LAS bf16x8*)(lds + PG8_SA(b, h) + aoff + m * 2048 + k * 1024); } while (0)
#define PG8_LDB(dst, b, h) do { _Pragma("unroll") for (int n = 0; n < 2; ++n) _Pragma("unroll") for (int k = 0; k < 2; ++k) dst[n][k] = *(const PG8_LAS bf16x8*)(lds + PG8_SB(b, h) + boff + n * 2048 + k * 1024); } while (0)
#define PG8_MMA(ai, bj, At, Bt) do { __builtin_amdgcn_s_setprio(1); _Pragma("unroll") for (int m = 0; m < 4; ++m) _Pragma("unroll") for (int n = 0; n < 2; ++n) _Pragma("unroll") for (int k = 0; k < 2; ++k) \
        acc[ai][bj][m][n] = __builtin_amdgcn_mfma_f32_16x16x32_bf16(Bt[n][k], At[m][k], acc[ai][bj][m][n], 0, 0, 0); __builtin_amdgcn_s_setprio(0); } while (0)
#define PG8_WAIT_V(n) asm volatile("s_waitcnt vmcnt(" #n ")" ::: "memory")
#define PG8_WAIT_L(n) asm volatile("s_waitcnt lgkmcnt(" #n ")" ::: "memory")
#define PG8_BAR __builtin_amdgcn_s_barrier()
#define PG8_SCHED __builtin_amdgcn_sched_barrier(0)
    Unit cur, nxt; int ui = 0;
    if (!S.next(0, cur)) return;
    f32x4 acc[2][2][4][2];
#pragma unroll
    for (int a = 0; a < 2; ++a)
#pragma unroll
        for (int b = 0; b < 2; ++b)
#pragma unroll
            for (int m = 0; m < 4; ++m)
#pragma unroll
                for (int n = 0; n < 2; ++n) acc[a][b][m][n] = (f32x4){0.f, 0.f, 0.f, 0.f};
    bf16x8 At[4][2], B0[2][2], B1[2][2];
    const char* cA = (const char*)g.A + (size_t)cur.pm * tstep + (size_t)cur.kofs * 2; const char* cB = (const char*)g.Bt + (size_t)cur.pn * tstep + (size_t)cur.kofs * 2;
    S.a_ready(cur);
    if constexpr (SP2) {
        PG8_STAGE(PG8_SB(0, 0), cB, voffB); PG8_STAGE(PG8_SB(0, 1), cB + hstep, voffB); PG8_STAGE(PG8_SA(0, 0), cA, voffA); PG8_STAGE(PG8_SA(0, 1), cA + hstep, voffA);
        if (wr == 1) PG8_BAR;
        PG8_WAIT_V(2); PG8_BAR;
        PG8_STAGE(PG8_SB(1, 0), cB + kstep, voffB); PG8_STAGE(PG8_SA(1, 0), cA + kstep, voffA); PG8_STAGE(PG8_SB(1, 1), cB + hstep + kstep, voffB);
        PG8_WAIT_V(6); PG8_BAR;
    } else {
        PG8_STAGE(PG8_SB(0, 0), cB, voffB); PG8_STAGE(PG8_SA(0, 0), cA, voffA); PG8_STAGE(PG8_SB(0, 1), cB + hstep, voffB); PG8_STAGE(PG8_SA(0, 1), cA + hstep, voffA);
        if (wr == 1) PG8_BAR;
        PG8_WAIT_V(4); PG8_BAR;
        PG8_STAGE(PG8_SB(1, 0), cB + kstep, voffB); PG8_STAGE(PG8_SA(1, 0), cA + kstep, voffA); PG8_STAGE(PG8_SB(1, 1), cB + hstep + kstep, voffB);
        PG8_WAIT_V(6); PG8_BAR;
    }
    for (;;) {
        const bool has_next = S.next(ui + 1, nxt);
        const char* nA = has_next ? (const char*)g.A + (size_t)nxt.pm * tstep + (size_t)nxt.kofs * 2 : cA; const char* nB = has_next ? (const char*)g.Bt + (size_t)nxt.pn * tstep + (size_t)nxt.kofs * 2 : cB;
        for (int t = 0; t < nt; t += 2) {
            const bool last = (t == nt - 2);
            const char* a1 = cA + (size_t)(t + 1) * kstep;
            const char* a2 = last ? nA : cA + (size_t)(t + 2) * kstep; const char* b2 = last ? nB : cB + (size_t)(t + 2) * kstep;
            const char* a3 = a2 + kstep; const char* b3 = b2 + kstep;
            if (last && has_next) S.a_ready(nxt);
            if constexpr (SP2) {
            PG8_LDB(B0, 0, 0); PG8_LDB(B1, 0, 1); PG8_SCHED; PG8_LDA(At, 0, 0); PG8_STAGE(PG8_SA(1, 1), a1 + hstep, voffA);
            PG8_WAIT_V(8); PG8_WAIT_L(0); PG8_BAR; PG8_MMA(0, 0, At, B0); PG8_MMA(0, 1, At, B1); PG8_BAR; PG8_SCHED;
            PG8_LDA(At, 0, 1); PG8_STAGE(PG8_SB(0, 0), b2, voffB); PG8_STAGE(PG8_SB(0, 1), b2 + hstep, voffB); PG8_STAGE(PG8_SA(0, 0), a2, voffA);
            PG8_WAIT_V(8); PG8_WAIT_L(0); PG8_BAR; PG8_MMA(1, 0, At, B0); PG8_MMA(1, 1, At, B1); PG8_BAR; PG8_SCHED;
            PG8_LDB(B0, 1, 0); PG8_LDB(B1, 1, 1); PG8_SCHED; PG8_LDA(At, 1, 0); PG8_STAGE(PG8_SA(0, 1), a2 + hstep, voffA);
            PG8_WAIT_V(8); PG8_WAIT_L(0); PG8_BAR; PG8_MMA(0, 0, At, B0); PG8_MMA(0, 1, At, B1); PG8_BAR; PG8_SCHED;
            PG8_LDA(At, 1, 1); PG8_STAGE(PG8_SB(1, 0), b3, voffB); PG8_STAGE(PG8_SB(1, 1), b3 + hstep, voffB); PG8_STAGE(PG8_SA(1, 0), a3, voffA);
            PG8_WAIT_V(8); PG8_WAIT_L(0); PG8_BAR; PG8_MMA(1, 0, At, B0); PG8_MMA(1, 1, At, B1); PG8_BAR; PG8_SCHED;
            } else {
            PG8_LDB(B0, 0, 0); PG8_SCHED; PG8_LDA(At, 0, 0); PG8_STAGE(PG8_SA(1, 1), a1 + hstep, voffA);
            PG8_WAIT_L(8); PG8_BAR; PG8_WAIT_L(0); PG8_MMA(0, 0, At, B0); PG8_BAR; PG8_SCHED;
            PG8_LDB(B1, 0, 1); PG8_STAGE(PG8_SB(0, 0), b2, voffB);
            PG8_BAR; PG8_WAIT_L(0); PG8_MMA(0, 1, At, B1); PG8_BAR;
            PG8_LDA(At, 0, 1); PG8_STAGE(PG8_SA(0, 0), a2, voffA);
            PG8_BAR; PG8_WAIT_L(0); PG8_MMA(1, 0, At, B0); PG8_BAR; PG8_SCHED;
            PG8_STAGE(PG8_SB(0, 1), b2 + hstep, voffB);
            PG8_WAIT_V(6); PG8_BAR; PG8_MMA(1, 1, At, B1); PG8_BAR;
            PG8_LDB(B0, 1, 0); PG8_SCHED; PG8_LDA(At, 1, 0); PG8_STAGE(PG8_SA(0, 1), a2 + hstep, voffA);
            PG8_WAIT_L(8); PG8_BAR; PG8_WAIT_L(0); PG8_MMA(0, 0, At, B0); PG8_BAR; PG8_SCHED;
            PG8_LDB(B1, 1, 1); PG8_STAGE(PG8_SB(1, 0), b3, voffB);
            PG8_BAR; PG8_WAIT_L(0); PG8_MMA(0, 1, At, B1); PG8_BAR;
            PG8_LDA(At, 1, 1); PG8_STAGE(PG8_SA(1, 0), a3, voffA);
            PG8_BAR; PG8_WAIT_L(0); PG8_MMA(1, 0, At, B0); PG8_BAR; PG8_SCHED;
            PG8_STAGE(PG8_SB(1, 1), b3 + hstep, voffB);
            PG8_WAIT_V(6); PG8_BAR; PG8_MMA(1, 1, At, B1); PG8_BAR;
            }
        }
        if constexpr (ALIGN_EPI) { if (wr == 0) PG8_BAR; }
        if constexpr (!Epi::AFTER_DRAIN) { E(acc, cur, wr, wc, fr, fq); S.done(cur); }
        if (!has_next) break;
#pragma unroll
        for (int a = 0; a < 2; ++a)
#pragma unroll
            for (int b = 0; b < 2; ++b)
#pragma unroll
                for (int m = 0; m < 4; ++m)
#pragma unroll
                    for (int n = 0; n < 2; ++n) acc[a][b][m][n] = (f32x4){0.f, 0.f, 0.f, 0.f};
        cur = nxt; cA = nA; cB = nB; ++ui;
        if constexpr (ALIGN_EPI) { if (wr == 1) PG8_BAR; }
    }
    PG8_WAIT_V(0);
    if constexpr (!ALIGN_EPI) { if (wr == 0) PG8_BAR; }
    PG8_BAR;
    if constexpr (Epi::AFTER_DRAIN) { E.fused(acc, cur, wr, wc, fr, fq, lds, wid, lane); S.done(cur); }
#undef PG8_SA
#undef PG8_SB
#undef PG8_STAGE
#undef PG8_LDA
#undef PG8_LDB
#undef PG8_MMA
#undef PG8_WAIT_V
#undef PG8_WAIT_L
#undef PG8_BAR
#undef PG8_SCHED
}
}

#define GAS __attribute__((address_space(1)))
#define LAS __attribute__((address_space(3)))
typedef unsigned short bf16;
typedef unsigned v4u __attribute__((ext_vector_type(4)));
typedef float f32x4 __attribute__((ext_vector_type(4)));
typedef short bf16x8 __attribute__((ext_vector_type(8)));
typedef GAS unsigned gu32;
typedef GAS unsigned long long gu64;
#define RLX_AGENT __ATOMIC_RELAXED, __HIP_MEMORY_SCOPE_AGENT
#define LDS_WAIT() asm volatile("s_waitcnt lgkmcnt(0)" ::: "memory")
#define VM_WAIT() asm volatile("s_waitcnt vmcnt(0)" ::: "memory")
__device__ __forceinline__ unsigned long long rt() { return __builtin_amdgcn_s_memrealtime(); }
__device__ __forceinline__ unsigned f2bf(float f) { unsigned u = __builtin_bit_cast(unsigned, f); return (u + 0x7fffu + ((u >> 16) & 1u)) >> 16; }
typedef float f32x2_t_ __attribute__((ext_vector_type(2))); typedef __bf16 bf16x2_t_ __attribute__((ext_vector_type(2)));
__device__ __forceinline__ unsigned pk2(float lo, float hi) { const bf16x2_t_ r = __builtin_convertvector((f32x2_t_){lo, hi}, bf16x2_t_); return __builtin_bit_cast(unsigned, r); }

#define XB_TMO      128
#define XB_XCNT(j)  (256  + 64 * (j))
#define XB_XSUB(j)  (1280 + 64 * (j))
#define XB_XGEN(j)  (2304 + 64 * (j))
#define XB_TOP      3328
#define XB_TOPGEN   3392
#define XCD_BAR_WORDS 3456
#define XB_SPIN_CAP (1u << 18)

__device__ __forceinline__ unsigned xb_ld(unsigned* p)              { return __hip_atomic_load(p, __ATOMIC_RELAXED, __HIP_MEMORY_SCOPE_AGENT); }
__device__ __forceinline__ unsigned xb_add(unsigned* p, unsigned v) { return __hip_atomic_fetch_add(p, v, __ATOMIC_RELAXED, __HIP_MEMORY_SCOPE_AGENT); }
__device__ __forceinline__ unsigned xb_xcc_id() { return (unsigned)__builtin_amdgcn_s_getreg((3 << 11) | 20) & 0xFu; }
#define XB_SPIN(cond, bar) do { unsigned _sp = 0; while (cond) { __builtin_amdgcn_s_sleep(1); \
    if ((++_sp & 255u) == 0u) { if (xb_ld(&(bar)[XB_TMO])) break; if (_sp > XB_SPIN_CAP) { atomicAdd(&(bar)[XB_TMO], 1u); break; } } } } while (0)

struct XcdBarrier {
    unsigned* bar; unsigned x;
    volatile LAS unsigned* st;
};

__device__ __forceinline__ XcdBarrier xcd_barrier_post(unsigned* bar, volatile LAS unsigned* st, const int tid) {
    XcdBarrier b; b.bar = bar; b.x = xb_xcc_id(); b.st = st;
    if (tid == 0) (void)xb_add(&bar[XB_XCNT(b.x)], 1u);
    return b;
}
__device__ __forceinline__ void xcd_barrier_complete(unsigned* bar, unsigned x, unsigned& nloc, unsigned& nx) {
    const unsigned G = gridDim.x * gridDim.y * gridDim.z;
    unsigned sum, cnt, mine, sp = 0u;
    for (;;) {
        sum = 0u; cnt = 0u; mine = 0u;
#pragma unroll
        for (unsigned j = 0; j < 16; ++j) { const unsigned c = xb_ld(&bar[XB_XCNT(j)]); sum += c; cnt += (c > 0u) ? 1u : 0u; mine = (j == x) ? c : mine; }
        if (sum == G) break;
        __builtin_amdgcn_s_sleep(1);
        if ((++sp & 255u) == 0u) { if (xb_ld(&bar[XB_TMO])) break; if (sp > XB_SPIN_CAP) { atomicAdd(&bar[XB_TMO], 1u); break; } }
    }
    nloc = mine > 0u ? mine : 1u; nx = cnt > 0u ? cnt : 1u;
}

__device__ __forceinline__ void xcd_barrier(const XcdBarrier& b, const int tid) {
    asm volatile("s_waitcnt vmcnt(0)" ::: "memory");
    __syncthreads();
    if (tid == 0) {
        unsigned* bar = b.bar;
        __builtin_amdgcn_s_waitcnt(0);
        unsigned nloc = b.st[0], nx = b.st[1];
        if (nloc == 0u) { xcd_barrier_complete(bar, b.x, nloc, nx); b.st[0] = nloc; b.st[1] = nx; }
        const unsigned old = xb_add(&bar[XB_XSUB(b.x)], 1u);
        const unsigned gen = old / nloc;
        if (old + 1u == (gen + 1u) * nloc) {
            __builtin_amdgcn_fence(__ATOMIC_RELEASE, "agent");
            asm volatile("s_waitcnt vmcnt(0)" ::: "memory");
            const unsigned og = xb_add(&bar[XB_TOP], 1u);
            const unsigned tg = og / nx;
            if (og + 1u == (tg + 1u) * nx) xb_add(&bar[XB_TOPGEN], 1u);
            else XB_SPIN(xb_ld(&bar[XB_TOPGEN]) == tg, bar);
            __builtin_amdgcn_fence(__ATOMIC_ACQUIRE, "agent");
            xb_add(&bar[XB_XGEN(b.x)], 1u);
            asm volatile("s_waitcnt vmcnt(0)" ::: "memory");
        } else {
            XB_SPIN(xb_ld(&bar[XB_XGEN(b.x)]) == gen, bar);
            __builtin_amdgcn_fence(__ATOMIC_ACQUIRE, "agent");
            asm volatile("s_waitcnt vmcnt(0)" ::: "memory");
        }
    }
    __syncthreads();
}


constexpr int NWAVES = 8, NTHREADS = 512;
constexpr int D = 1024, SEQ = 8192, NMETA = 16, DECB = 128, DECT = 8, DEPTH = 2;
constexpr int R_SAMPLE = 16384, R_META = 17408, MROWS = 17440, MPAD = 17664;
constexpr int NPROJ = 3584, DFF = 2816, NFF2 = 5632, DIN = 3596;
constexpr int C_DNQ = 0, C_DNK = 512, C_DNV = 1024, C_DNZ = 1536, C_SSX = 2048, C_SSZ = 2816, C_SWQ = 3072, C_SWK = 3328, C_SWV = 3456;
constexpr int NCHUNK = 129;
constexpr int NSWAB = 65;
constexpr float EPS = 1e-6f;
enum { I_XP = 0, I_XS, I_SDN, I_SDNC, I_SSSM, I_SSSMC, I_CK, I_CV, I_META, I_WIN, I_DNCW, I_DNALOG, I_DNDTB, I_DNNW, I_SSCW, I_SSCB, I_SSALOG, I_SSDTB, I_SSD, I_SSNW, I_SINK,
       I_WOUT, I_GPM, I_GPOM, I_GPF, I_GPOF, I_WFI, I_WFO, N_IN };
constexpr size_t O_YP = 0, O_YS = O_YP + (size_t)2 * SEQ * D, O_DNP = O_YS + (size_t)DECB * DECT * D, O_DNCP = O_DNP + 2 * 2 * 4 * 128 * 128, O_SSMP = O_DNCP + 2 * 2 * 3 * 1536,
                 O_SSMCP = O_SSMP + 2 * 2 * 4 * 64 * 128, O_KP = O_SSMCP + 2 * 2 * 3 * 768, O_VP = O_KP + 2 * 2 * 128 * 128, O_DNS = O_VP + 2 * 2 * 128 * 128,
                 O_DNCS = O_DNS + (size_t)2 * DECB * 4 * 128 * 128, O_SSMS = O_DNCS + (size_t)2 * DECB * 3 * 1536, O_SSMCS = O_SSMS + (size_t)2 * DECB * 4 * 64 * 128,
                 O_KS = O_SSMCS + (size_t)2 * DECB * 3 * 768, O_VS = O_KS + (size_t)2 * DECB * 128 * 128, O_END = O_VS + (size_t)2 * DECB * 128 * 128;
constexpr size_t MiB = 1u << 20;
constexpr size_t WS_CTL = 0, CTL_ZERO_BYTES = 64 * 1024;
constexpr size_t WS_DNGL = 512 * 1024, WS_SSGL = 640 * 1024;
constexpr size_t WS_SMALL = 1 * MiB;
constexpr size_t WS_XMETA = 3 * MiB;
constexpr size_t WS_WIN = 4 * MiB;
constexpr size_t WS_MIXED = 11 * MiB;
constexpr size_t WS_PROJ = 46 * MiB;
constexpr size_t WS_XN = 167 * MiB;
constexpr size_t WS_MOUT = 202 * MiB;
constexpr size_t WS_WOUT = 237 * MiB, WS_WFI = 239 * MiB, WS_WFO = 250 * MiB;
constexpr size_t DNREC_BYTES = 98304, SSMREC_BYTES = 40960, DNST_BYTES = 32768, SSMST_BYTES = 16384;
constexpr size_t WS_DNREC = 256 * MiB;
constexpr size_t WS_DNST = 353 * MiB;
constexpr size_t WS_SSMREC = 386 * MiB;
constexpr size_t WS_SSMST = 427 * MiB;
constexpr size_t WS_PART = 444 * MiB;
constexpr size_t WS_END = 500 * MiB;
constexpr int TAIL_S2 = 8, TAIL_K2 = 128, TAIL_S4 = 11, TAIL_K4 = 256;
static_assert(WS_DNREC + (size_t)1032 * DNREC_BYTES <= WS_DNST && WS_DNST + (size_t)1032 * DNST_BYTES <= WS_SSMREC && WS_SSMREC + (size_t)1032 * SSMREC_BYTES <= WS_SSMST && WS_SSMST + (size_t)1032 * SSMST_BYTES <= WS_PART && WS_PART + (size_t)11 * 1280 * 1024 * 4 <= WS_END, "ws map");
static_assert(WS_MIXED + (size_t)MPAD * 1024 * 2 <= WS_PROJ && WS_PROJ + (size_t)MPAD * NPROJ * 2 <= WS_XN && WS_XN + (size_t)MPAD * 2048 <= WS_MOUT && WS_MOUT + (size_t)MPAD * 2048 <= WS_WOUT, "ws map 2");
static_assert(WS_WFO + (size_t)1024 * DFF * 2 <= WS_DNREC && WS_WFI + (size_t)NFF2 * 1024 * 2 <= WS_WFO, "ws map 3");
constexpr int CW_TMO = 0, CW_BAR = 1024;
constexpr int R_P = 0, R_RT = 32768, R_QP = 65536, R_O0 = 81920;
constexpr int S_DH = 0, S_CD = 16384, S_YIN = 32768;
constexpr int LDS_BYTES = 160 * 1024;
constexpr int LDSCTL_OFF = 159 * 1024;

typedef short bf16x4 __attribute__((ext_vector_type(4)));
typedef unsigned u32x2 __attribute__((ext_vector_type(2)));

__device__ __forceinline__ float bf2f(unsigned short h) { return __uint_as_float((unsigned)h << 16); }
__device__ __forceinline__ float bflo(unsigned u) { return __uint_as_float(u << 16); }
__device__ __forceinline__ float bfhi(unsigned u) { return __uint_as_float(u & 0xffff0000u); }
__device__ __forceinline__ float siluf(float x) { return x * __builtin_amdgcn_rcpf(1.f + __expf(-x)); }
__device__ __forceinline__ float sigmoidf_(float x) { return __builtin_amdgcn_rcpf(1.f + __expf(-x)); }
__device__ __forceinline__ float softplusf_(float x) { const float e = __expf(x); return x > 20.f ? x : (e < 1e-3f ? e * (1.f - 0.5f * e) : __logf(1.f + e)); }
__device__ __forceinline__ f32x4 mma16(bf16x8 x, bf16x8 y, f32x4 c) { return __builtin_amdgcn_mfma_f32_16x16x32_bf16(x, y, c, 0, 0, 0); }
__device__ __forceinline__ int swz(int row, int byte, int RB) { return row * RB + (byte ^ ((row & 7) << 4)); }
__device__ __forceinline__ int row_of_tp(int b, int tp) { return tp < 16 ? R_META + b * 16 + tp : b * SEQ + tp - 16; }
__device__ __forceinline__ v4u pack8(const float* v) { v4u o; o.x = pk2(v[0], v[1]); o.y = pk2(v[2], v[3]); o.z = pk2(v[4], v[5]); o.w = pk2(v[6], v[7]); return o; }
__device__ __forceinline__ u32x2 pack4(float a, float b, float c, float d) { u32x2 o; o.x = pk2(a, b); o.y = pk2(c, d); return o; }
__device__ __forceinline__ void unpack8(v4u r, float* v) { v[0] = bflo(r.x); v[1] = bfhi(r.x); v[2] = bflo(r.y); v[3] = bfhi(r.y); v[4] = bflo(r.z); v[5] = bfhi(r.z); v[6] = bflo(r.w); v[7] = bfhi(r.w); }
__device__ __forceinline__ float wave_sum(float v) {
#pragma unroll
    for (int o = 1; o < 64; o <<= 1) v += __shfl_xor(v, o);
    return v;
}
__device__ __forceinline__ float wave_max(float v) {
#pragma unroll
    for (int o = 1; o < 64; o <<= 1) v = fmaxf(v, __shfl_xor(v, o));
    return v;
}
__device__ __forceinline__ float wave_incl_scan(float v, int lane) {
#pragma unroll
    for (int o = 1; o < 64; o <<= 1) { const float t = __int_as_float(__builtin_amdgcn_ds_bpermute(((lane - o) & 63) << 2, __float_as_int(v))); if (lane >= o) v += t; }
    return v;
}
__device__ __forceinline__ float lane_bcast(float v, int src) { return __int_as_float(__builtin_amdgcn_readlane(__float_as_int(v), src)); }
__device__ __forceinline__ float dpp_sum16(float v) {
    v += __int_as_float(__builtin_amdgcn_update_dpp(0, __float_as_int(v), 0xB1, 0xF, 0xF, false));
    v += __int_as_float(__builtin_amdgcn_update_dpp(0, __float_as_int(v), 0x4E, 0xF, 0xF, false));
    v += __int_as_float(__builtin_amdgcn_update_dpp(0, __float_as_int(v), 0x141, 0xF, 0xF, false));
    v += __int_as_float(__builtin_amdgcn_update_dpp(0, __float_as_int(v), 0x140, 0xF, 0xF, false));
    return v;
}
#define BAR_LDS() do { asm volatile("s_waitcnt lgkmcnt(0)" ::: "memory"); __builtin_amdgcn_s_barrier(); asm volatile("" ::: "memory"); } while (0)
#define BAR_ALL() do { asm volatile("s_waitcnt vmcnt(0) lgkmcnt(0)" ::: "memory"); __builtin_amdgcn_s_barrier(); asm volatile("" ::: "memory"); } while (0)

struct Args { const float* in[N_IN]; float* out; unsigned char* ws; int ph_lo, ph_hi; };
typedef const __attribute__((address_space(4))) Args* KaPtr;
struct KaIn { KaPtr ka; __device__ __forceinline__ const float* operator[](int i) const { return ka->in[i]; } };
struct Frame {
    LAS unsigned char* lds;
    int tid, lane, wave, vcu, G;
    KaIn in;
    float* out; unsigned char* ws;
};
__device__ __forceinline__ unsigned char* dnrec_ptr(unsigned char* ws, int b, int c, int h) { return ws + WS_DNREC + (size_t)((b * NCHUNK + c) * 4 + h) * DNREC_BYTES; }
__device__ __forceinline__ unsigned char* dnst_ptr(unsigned char* ws, int b, int c, int h) { return ws + WS_DNST + (size_t)((b * NCHUNK + c) * 4 + h) * DNST_BYTES; }
__device__ __forceinline__ unsigned char* ssmrec_ptr(unsigned char* ws, int b, int c, int h) { return ws + WS_SSMREC + (size_t)((b * NCHUNK + c) * 4 + h) * SSMREC_BYTES; }
__device__ __forceinline__ unsigned char* ssmst_ptr(unsigned char* ws, int b, int c, int h) { return ws + WS_SSMST + (size_t)((b * NCHUNK + c) * 4 + h) * SSMST_BYTES; }
__device__ __forceinline__ float* xres_row(Frame& F, int row) { return row < R_META ? F.out + (size_t)row * D : (float*)(F.ws + WS_XMETA) + (size_t)(row - R_META) * D; }
__device__ __forceinline__ const float* xin_row(Frame& F, int row) { return row < R_SAMPLE ? F.in[I_XP] + (size_t)row * D : row < R_META ? F.in[I_XS] + (size_t)(row - R_SAMPLE) * D : F.in[I_META] + (size_t)((row - R_META) & 15) * D; }

__device__ __forceinline__ void transpose_item(const float* W, int ldw, int K, int srccol0, bf16* WT, int dstrow0, int k0, LAS float* scr, int lane) {
#pragma unroll 8
    for (int i = 0; i < 32; ++i) { const int kk = 2 * i + (lane >> 5); scr[kk * 33 + (lane & 31)] = W[(size_t)(k0 + kk) * ldw + srccol0 + (lane & 31)]; }
    LDS_WAIT(); asm volatile("" ::: "memory");
    const int c = lane & 7;
#pragma unroll
    for (int j = 0; j < 4; ++j) { const int n = (lane >> 3) + 8 * j; const LAS float* s = scr + (8 * c) * 33 + n;
        v4u o; o.x = pk2(s[0 * 33], s[1 * 33]); o.y = pk2(s[2 * 33], s[3 * 33]); o.z = pk2(s[4 * 33], s[5 * 33]); o.w = pk2(s[6 * 33], s[7 * 33]);
        *(v4u*)(WT + (size_t)(dstrow0 + n) * K + k0 + 8 * c) = o; }
    LDS_WAIT(); asm volatile("" ::: "memory");
}
__device__ __forceinline__ void convert_weight(Frame& F, int which, int l, int gw, int NGW) {
    LAS float* scr = (LAS float*)(F.lds + F.wave * 16384);
    const float* W; int ldw, K, N; bf16* WT;
    if (which == 0) { W = F.in[I_WIN] + (size_t)l * D * DIN; ldw = DIN; K = D; N = NPROJ; WT = (bf16*)(F.ws + WS_WIN); }
    else if (which == 1) { W = F.in[I_WOUT] + (size_t)l * D * D; ldw = D; K = D; N = D; WT = (bf16*)(F.ws + WS_WOUT); }
    else if (which == 2) { W = F.in[I_WFI] + (size_t)l * D * NFF2; ldw = NFF2; K = D; N = NFF2; WT = (bf16*)(F.ws + WS_WFI); }
    else { W = F.in[I_WFO] + (size_t)l * DFF * D; ldw = D; K = DFF; N = D; WT = (bf16*)(F.ws + WS_WFO); }
    const int nblk = N / 32, nitems = (K / 64) * nblk;
    for (int it = gw; it < nitems; it += NGW) {
        const int kb = it / nblk, nb = it % nblk, base = 32 * nb; int src;
        if (which == 0) src = base + (base >= 3072 ? 12 : base >= 2048 ? 8 : 0);
        else if (which == 2) { const int tile = base >> 8, within = base & 255; src = within < 128 ? 128 * tile + within : DFF + 128 * tile + within - 128; }
        else src = base;
        transpose_item(W, ldw, K, src, WT, base, 64 * kb, scr, F.lane);
    }
}

template <int MODE> __device__ __forceinline__ void phase_norm(Frame& F, int l) {
    const bool do_small = (MODE == 0) || (MODE == 2 && l == 0);
    const bool do_xn = (MODE != 2) || (l == 0);
    const int lw = (MODE == 0) ? 0 : 1;
    LAS float* wsm = (LAS float*)F.lds;
    __syncthreads();
    if (do_small) {
        const float* W = F.in[I_WIN] + (size_t)lw * D * DIN;
        for (int idx = F.tid; idx < 12 * 1024; idx += NTHREADS) { const int k = idx / 12, cc = idx % 12; wsm[cc * 1024 + k] = W[(size_t)k * DIN + (cc < 8 ? 2048 + cc : 3080 + cc - 8)]; }
    }
    __syncthreads();
    const float* gpost = MODE == 1 ? F.in[I_GPOM] + l * D : F.in[I_GPOF] + l * D;
    const float* gnext = MODE == 0 ? F.in[I_GPM] : MODE == 1 ? F.in[I_GPF] + l * D : F.in[I_GPM] + D;
    const bf16* MOUT = (const bf16*)(F.ws + WS_MOUT); bf16* XN = (bf16*)(F.ws + WS_XN); float* SMALL = (float*)(F.ws + WS_SMALL);
    const int gw = F.vcu * NWAVES + F.wave, NGW = F.G * NWAVES, lane = F.lane;
    for (int row = gw; row < MROWS; row += NGW) {
        f32x4 v[4];
        const float* xs = (MODE == 0 || (MODE == 1 && l == 0)) ? xin_row(F, row) : xres_row(F, row);
#pragma unroll
        for (int j = 0; j < 4; ++j) v[j] = *(const f32x4*)(xs + lane * 4 + 256 * j);
        if (MODE != 0) {
            f32x4 m[4]; float ss = 0.f;
            if (row < R_SAMPLE) {
#pragma unroll
                for (int j = 0; j < 4; ++j) { const u32x2 r = *(const u32x2*)(MOUT + (size_t)row * D + lane * 4 + 256 * j); m[j] = (f32x4){bflo(r.x), bfhi(r.x), bflo(r.y), bfhi(r.y)}; }
            } else {
                constexpr int NS = MODE == 1 ? TAIL_S2 : TAIL_S4; const float* P = (const float*)(F.ws + WS_PART) + (size_t)(row - R_SAMPLE) * 1024 + lane * 4;
#pragma unroll
                for (int j = 0; j < 4; ++j) m[j] = *(const f32x4*)(P + 256 * j);
#pragma unroll 2
                for (int s = 1; s < NS; ++s)
#pragma unroll
                    for (int j = 0; j < 4; ++j) m[j] += *(const f32x4*)(P + (size_t)s * 1280 * 1024 + 256 * j);
            }
#pragma unroll
            for (int j = 0; j < 4; ++j) ss += (m[j].x * m[j].x + m[j].y * m[j].y) + (m[j].z * m[j].z + m[j].w * m[j].w);
            const float rs = rsqrtf(wave_sum(ss) * (1.f / D) + EPS);
            float* xo = xres_row(F, row);
#pragma unroll
            for (int j = 0; j < 4; ++j) { const f32x4 g = *(const f32x4*)(gpost + lane * 4 + 256 * j); v[j] = v[j] + m[j] * rs * g; *(f32x4*)(xo + lane * 4 + 256 * j) = v[j]; }
        }
        if (do_xn) {
            float ss = 0.f;
#pragma unroll
            for (int j = 0; j < 4; ++j) ss += (v[j].x * v[j].x + v[j].y * v[j].y) + (v[j].z * v[j].z + v[j].w * v[j].w);
            const float rs = rsqrtf(wave_sum(ss) * (1.f / D) + EPS);
#pragma unroll
            for (int j = 0; j < 4; ++j) { const f32x4 g = *(const f32x4*)(gnext + lane * 4 + 256 * j); v[j] = v[j] * rs * g;
                *(u32x2*)(XN + (size_t)row * D + lane * 4 + 256 * j) = pack4(v[j].x, v[j].y, v[j].z, v[j].w); }
            if (do_small) {
#pragma unroll 4
                for (int cc = 0; cc < 12; ++cc) { float p = 0.f;
#pragma unroll
                    for (int j = 0; j < 4; ++j) { const f32x4 w = *(const LAS f32x4*)(wsm + cc * 1024 + lane * 4 + 256 * j); p += (v[j].x * w.x + v[j].y * w.y) + (v[j].z * w.z + v[j].w * w.w); }
                    p = wave_sum(p);
                    if (lane == 0) SMALL[(size_t)row * 16 + cc] = p; }
            }
        }
    }
    __syncthreads();
}


#ifndef PROBE_DN1S
#define PROBE_DN1S 0
#endif
__device__ __forceinline__ void dn1_unit(Frame& F, int l, int b, int c, int h) {
    LAS unsigned char* lds = F.lds;
    unsigned long long ts_ = PROBE_DN1S ? __builtin_amdgcn_s_memrealtime() : 0ull;
    constexpr int L_Q = 0, L_K = 16384, L_V = 32768, L_A = 49152, L_ATT = 65536, L_UT = 73728, L_WT = 90112, L_KDT = 106496, L_GC = 122880, L_BETA = 123136, L_EG = 123392, L_EGL = 123648, L_AZB = 124928, L_T = 133120;
    int tid = F.tid; asm volatile("" : "+v"(tid)); const int lane = tid & 63, wave = __builtin_amdgcn_readfirstlane(tid >> 6);
    const bf16* PROJ = (const bf16*)(F.ws + WS_PROJ);
    unsigned char* rec = dnrec_ptr(F.ws, b, c, h);
    LAS float* GC = (LAS float*)(lds + L_GC); LAS float* BETA = (LAS float*)(lds + L_BETA); LAS float* EG = (LAS float*)(lds + L_EG); LAS float* EGL = (LAS float*)(lds + L_EGL);
#pragma unroll
    for (int i = 0; i < 4; ++i) *(LAS v4u*)(lds + L_UT + (tid * 4 + i) * 16) = (v4u){0u, 0u, 0u, 0u};
    if (tid < 384) {
        const int g16 = tid >> 4, strip = g16 / 3, part = g16 % 3, cgi = tid & 15;
        const int ch = part * 512 + h * 128 + cgi * 8;
        float w[4][8];
        const float* cw = F.in[I_DNCW] + (size_t)l * 4 * 1536 + ch;
#pragma unroll
        for (int i = 0; i < 4; ++i) { const f32x4 a = *(const f32x4*)(cw + i * 1536), b4 = *(const f32x4*)(cw + i * 1536 + 4);
            w[i][0] = a.x; w[i][1] = a.y; w[i][2] = a.z; w[i][3] = a.w; w[i][4] = b4.x; w[i][5] = b4.y; w[i][6] = b4.z; w[i][7] = b4.w; }
        const int tp0 = 64 * c + strip * 8 - 48;
        v4u rawr[11];
#pragma unroll
        for (int rr = 0; rr < 11; ++rr) { const int tp = tp0 - 3 + rr; rawr[rr] = tp >= 0 ? *(const v4u*)(PROJ + (size_t)row_of_tp(b, tp) * NPROJ + ch) : (v4u){0u, 0u, 0u, 0u}; }
        float win[3][8];
#pragma unroll
        for (int rr = 0; rr < 3; ++rr) unpack8(rawr[rr], win[rr]);
        LAS unsigned char* dst = lds + (part == 0 ? L_Q : part == 1 ? L_K : L_V);
#pragma unroll
        for (int tt = 0; tt < 8; ++tt) {
            const int tp = tp0 + tt; float cur[8]; unpack8(rawr[3 + tt], cur);
            float o[8]; float ss = 0.f;
#pragma unroll
            for (int e = 0; e < 8; ++e) { const float a = w[0][e] * win[0][e] + w[1][e] * win[1][e] + w[2][e] * win[2][e] + w[3][e] * cur[e]; o[e] = (tp >= 0) ? siluf(a) : 0.f; ss += o[e] * o[e];
                win[0][e] = win[1][e]; win[1][e] = win[2][e]; win[2][e] = cur[e]; }
            ss = dpp_sum16(ss);
            if (part < 2) { const float rn = rsqrtf(ss + EPS) * (part == 0 ? 0.08838834764831845f : 1.f);
#pragma unroll
                for (int e = 0; e < 8; ++e) o[e] *= rn; }
            *(LAS v4u*)(dst + swz(strip * 8 + tt, cgi * 16, 256)) = pack8(o);
        }
        if (c == NCHUNK - 1 && strip == 7) {
            float* o = F.out + O_DNCP + (size_t)((l * 2 + b) * 3) * 1536 + ch;
#pragma unroll
            for (int j = 0; j < 3; ++j) { *(f32x4*)(o + j * 1536) = (f32x4){win[j][0], win[j][1], win[j][2], win[j][3]}; *(f32x4*)(o + j * 1536 + 4) = (f32x4){win[j][4], win[j][5], win[j][6], win[j][7]}; }
        }
    } else if (tid >= 448) {
        const int tp = 64 * c + lane - 48; float beta = 0.f, g = 0.f;
        if (tp >= 0) { const float* sm = (const float*)(F.ws + WS_SMALL) + (size_t)row_of_tp(b, tp) * 16;
            beta = sigmoidf_(sm[h]); g = -__expf(F.in[I_DNALOG][l * 4 + h]) * softplusf_(sm[4 + h] + F.in[I_DNDTB][l * 4 + h]); }
        const float gc = wave_incl_scan(g, lane); const float g63 = lane_bcast(gc, 63);
        GC[lane] = gc; BETA[lane] = beta; EG[lane] = __expf(gc); EGL[lane] = __expf(g63 - gc);
        if (lane == 0) ((float*)(F.ws + WS_DNGL))[(b * 4 + h) * 132 + c] = __expf(g63);
    }
    __syncthreads();
    if (PROBE_DN1S == 1) { const unsigned long long tq_ = __builtin_amdgcn_s_memrealtime(); const unsigned long long te_ = tq_ + 4 * (tq_ - ts_); while (__builtin_amdgcn_s_memrealtime() < te_) __builtin_amdgcn_s_sleep(8); } ts_ = PROBE_DN1S ? __builtin_amdgcn_s_memrealtime() : 0ull;
    {
        const int mat = wave >> 2, mi = wave & 3, fr = lane & 15, fq = lane >> 4;
        const int i = 16 * mi + fr; const float gci = GC[i], bi = BETA[i];
        for (int nj = 0; nj < 4; ++nj) {
            f32x4 acc = {0.f, 0.f, 0.f, 0.f};
            if (nj <= mi) {
#pragma unroll
                for (int kk = 0; kk < 4; ++kk) { const bf16x8 x = *(const LAS bf16x8*)(lds + L_K + swz(16 * nj + fr, 64 * kk + 16 * fq, 256));
                    const bf16x8 y = *(const LAS bf16x8*)(lds + (mat == 0 ? L_K : L_Q) + swz(i, 64 * kk + 16 * fq, 256)); acc = mma16(x, y, acc); }
            }
            float o[4];
#pragma unroll
            for (int r = 0; r < 4; ++r) { const int j = 16 * nj + 4 * fq + r; const bool ok = mat == 0 ? (j < i) : (j <= i); o[r] = ok ? acc[r] * __expf(gci - GC[j]) * (mat == 0 ? bi : 1.f) : 0.f; }
            if (mat == 0) { *(LAS f32x4*)(lds + L_A + (i * 64 + 16 * nj + 4 * fq) * 4) = (f32x4){o[0], o[1], o[2], o[3]};
                *(LAS u32x2*)(lds + L_AZB + swz(i, 2 * (16 * nj + 4 * fq), 128)) = nj < mi ? pack4(-o[0], -o[1], -o[2], -o[3]) : (u32x2){0u, 0u}; }
            else *(LAS u32x2*)(lds + L_ATT + swz(i, 2 * (16 * nj + 4 * fq), 128)) = pack4(o[0], o[1], o[2], o[3]);
        }
    }
    __syncthreads();
    if (PROBE_DN1S == 2) { const unsigned long long tq_ = __builtin_amdgcn_s_memrealtime(); const unsigned long long te_ = tq_ + 4 * (tq_ - ts_); while (__builtin_amdgcn_s_memrealtime() < te_) __builtin_amdgcn_s_sleep(8); } ts_ = PROBE_DN1S ? __builtin_amdgcn_s_memrealtime() : 0ull;
    {
        const int d = tid & 127, iq = tid >> 7;
#pragma unroll
        for (int i0 = 0; i0 < 16; i0 += 8) { float v[8];
#pragma unroll
            for (int k = 0; k < 8; ++k) { const int i = 16 * iq + i0 + k; v[k] = bf2f(*(const LAS unsigned short*)(lds + L_K + swz(i, 2 * d, 256))) * EGL[i]; }
            *(LAS v4u*)(lds + L_KDT + swz(d, 2 * (16 * iq + i0), 128)) = pack8(v); }
    }
    if (wave < 4 && lane < 16) {
        const int k = wave, j = lane; float t[16];
#pragma unroll
        for (int i = 0; i < 16; ++i) { float a = (i == j) ? 1.f : 0.f;
#pragma unroll
            for (int m4 = 0; m4 < (i + 3) / 4; ++m4) { const f32x4 ar = *(const LAS f32x4*)(lds + L_A + ((16 * k + i) * 64 + 16 * k + 4 * m4) * 4);
                if (4 * m4 + 0 < i) a -= ar.x * t[4 * m4 + 0]; if (4 * m4 + 1 < i) a -= ar.y * t[4 * m4 + 1]; if (4 * m4 + 2 < i) a -= ar.z * t[4 * m4 + 2]; if (4 * m4 + 3 < i) a -= ar.w * t[4 * m4 + 3]; }
            t[i] = a; *(LAS unsigned short*)(lds + L_T + k * 512 + i * 32 + j * 2) = (unsigned short)f2bf(a); }
    }
    __syncthreads();
    {
        const int fr = lane & 15, fq = lane >> 4;
#pragma unroll
        for (int ct2 = 0; ct2 < 2; ++ct2) { const int cc = 16 * (2 * wave + ct2) + fr; const int colb = (cc & 127) * 2; const int srcoff = cc < 128 ? L_V : L_K;
#pragma unroll
            for (int k = 0; k < 4; ++k) {
                f32x4 acc;
#pragma unroll
                for (int r = 0; r < 4; ++r) { const int i = 16 * k + 4 * fq + r; const float rv = bf2f(*(const LAS unsigned short*)(lds + srcoff + swz(i, colb, 256))); acc[r] = rv * BETA[i] * (cc < 128 ? 1.f : EG[i]); }
                if (k >= 1) acc = mma16(*(const LAS bf16x8*)(lds + L_AZB + swz(16 * k + fr, 16 * fq, 128)), *(const LAS bf16x8*)(lds + L_UT + swz(cc, 16 * fq, 128)), acc);
                if (k == 3) acc = mma16(*(const LAS bf16x8*)(lds + L_AZB + swz(16 * k + fr, 64 + 16 * fq, 128)), *(const LAS bf16x8*)(lds + L_UT + swz(cc, 64 + 16 * fq, 128)), acc);
                const u32x2 tr = *(const LAS u32x2*)(lds + L_T + k * 512 + fr * 32 + fq * 8);
                const v4u xt = {tr.x, tr.y, 0u, 0u}; const u32x2 ya = pack4(acc[0], acc[1], acc[2], acc[3]); const v4u yt = {ya.x, ya.y, 0u, 0u};
                const f32x4 sol = mma16(__builtin_bit_cast(bf16x8, xt), __builtin_bit_cast(bf16x8, yt), (f32x4){0.f, 0.f, 0.f, 0.f});
                *(LAS u32x2*)(lds + L_UT + swz(cc, 2 * (16 * k + 4 * fq), 128)) = pack4(sol[0], sol[1], sol[2], sol[3]);
            } }
    }
    __syncthreads();
    if (PROBE_DN1S == 3) { const unsigned long long tq_ = __builtin_amdgcn_s_memrealtime(); const unsigned long long te_ = tq_ + 4 * (tq_ - ts_); while (__builtin_amdgcn_s_memrealtime() < te_) __builtin_amdgcn_s_sleep(8); } ts_ = PROBE_DN1S ? __builtin_amdgcn_s_memrealtime() : 0ull;
    {
        const int fr = lane & 15, fq = lane >> 4;
        {
            bf16x8 kf[2];
#pragma unroll
            for (int kk = 0; kk < 2; ++kk) kf[kk] = *(const LAS bf16x8*)(lds + L_KDT + swz(16 * wave + fr, 64 * kk + 16 * fq, 128));
#pragma unroll
            for (int mt = 0; mt < 8; ++mt) { f32x4 acc = {0.f, 0.f, 0.f, 0.f};
#pragma unroll
                for (int kk = 0; kk < 2; ++kk) acc = mma16(*(const LAS bf16x8*)(lds + L_WT + swz(16 * mt + fr, 64 * kk + 16 * fq, 128)), kf[kk], acc);
                { const int din = 16 * mt + 4 * fq; *(u32x2*)(rec + R_P + (((wave * 4 + (din >> 5)) * 64 + ((din >> 3) & 3) * 16 + fr) * 16 + (din & 7) * 2)) = pack4(-acc[0], -acc[1], -acc[2], -acc[3]); } }
        }
        {
            bf16x8 uf[2];
#pragma unroll
            for (int kk = 0; kk < 2; ++kk) uf[kk] = *(const LAS bf16x8*)(lds + L_UT + swz(16 * wave + fr, 64 * kk + 16 * fq, 128));
            const int col = 16 * wave + fr;
#pragma unroll
            for (int mt = 0; mt < 8; ++mt) { f32x4 acc = {0.f, 0.f, 0.f, 0.f};
#pragma unroll
                for (int kk = 0; kk < 2; ++kk) acc = mma16(*(const LAS bf16x8*)(lds + L_KDT + swz(16 * mt + fr, 64 * kk + 16 * fq, 128)), uf[kk], acc);
                *(u32x2*)(rec + R_RT + (((((col >> 5) * 8 + mt) * 2 + ((col >> 4) & 1)) * 64 + fq * 16 + (col & 15)) * 8)) = pack4(acc[0], acc[1], acc[2], acc[3]); }
        }
        {
            const int tt = wave & 3, hf = wave >> 2, t = 16 * tt + fr; const float eg = EG[t];
            bf16x8 af[2];
#pragma unroll
            for (int kk = 0; kk < 2; ++kk) af[kk] = *(const LAS bf16x8*)(lds + L_ATT + swz(t, 64 * kk + 16 * fq, 128));
#pragma unroll
            for (int m4 = 0; m4 < 4; ++m4) { const int mt = 4 * hf + m4;
                f32x4 acc = {0.f, 0.f, 0.f, 0.f}, acc2 = {0.f, 0.f, 0.f, 0.f};
#pragma unroll
                for (int kk = 0; kk < 2; ++kk) { acc = mma16(*(const LAS bf16x8*)(lds + L_WT + swz(16 * mt + fr, 64 * kk + 16 * fq, 128)), af[kk], acc);
                    acc2 = mma16(*(const LAS bf16x8*)(lds + L_UT + swz(16 * mt + fr, 64 * kk + 16 * fq, 128)), af[kk], acc2); }
                const bf16x4 q4 = *(const LAS bf16x4*)(lds + L_Q + swz(t, 2 * (16 * mt + 4 * fq), 256));
                *(u32x2*)(rec + R_QP + swz(t, 2 * (16 * mt + 4 * fq), 256)) = pack4(bf2f((unsigned short)q4[0]) * eg - acc[0], bf2f((unsigned short)q4[1]) * eg - acc[1], bf2f((unsigned short)q4[2]) * eg - acc[2], bf2f((unsigned short)q4[3]) * eg - acc[3]);
                *(u32x2*)(rec + R_O0 + (t * 128 + 16 * mt + 4 * fq) * 2) = pack4(acc2[0], acc2[1], acc2[2], acc2[3]); }
        }
    }
    __syncthreads();
    if (PROBE_DN1S == 4) { const unsigned long long tq_ = __builtin_amdgcn_s_memrealtime(); const unsigned long long te_ = tq_ + 4 * (tq_ - ts_); while (__builtin_amdgcn_s_memrealtime() < te_) __builtin_amdgcn_s_sleep(8); } ts_ = PROBE_DN1S ? __builtin_amdgcn_s_memrealtime() : 0ull;
}

__device__ __forceinline__ void ssm1_unit(Frame& F, int l, int b, int c, int g) {
    LAS unsigned char* lds = F.lds;
    constexpr int L_XS = 0, L_B = 32768, L_C = 49152, L_CB = 65536, L_ATT = 81920, L_XDTT = 98304, L_DT = 114688, L_GC = 115200, L_EG = 115712, L_EGL = 116224, L_BDT = 116736;
    int tid = F.tid; asm volatile("" : "+v"(tid)); const int lane = tid & 63, wave = __builtin_amdgcn_readfirstlane(tid >> 6);
    const bf16* PROJ = (const bf16*)(F.ws + WS_PROJ);
    LAS float* XS = (LAS float*)(lds + L_XS); LAS float* CB = (LAS float*)(lds + L_CB);
    LAS float* DT = (LAS float*)(lds + L_DT); LAS float* GC = (LAS float*)(lds + L_GC); LAS float* EG = (LAS float*)(lds + L_EG); LAS float* EGL = (LAS float*)(lds + L_EGL);
    if (tid < 384) {
        const int g16 = tid >> 4, strip = g16 / 3, part = g16 % 3, cgi = tid & 15;
        const int ch = part * 256 + g * 128 + cgi * 8;
        float w[4][8], bias[8];
        const float* cw = F.in[I_SSCW] + (size_t)l * 4 * 768 + ch;
#pragma unroll
        for (int i = 0; i < 4; ++i) { const f32x4 a = *(const f32x4*)(cw + i * 768), b4 = *(const f32x4*)(cw + i * 768 + 4);
            w[i][0] = a.x; w[i][1] = a.y; w[i][2] = a.z; w[i][3] = a.w; w[i][4] = b4.x; w[i][5] = b4.y; w[i][6] = b4.z; w[i][7] = b4.w; }
        { const float* cb = F.in[I_SSCB] + l * 768 + ch; const f32x4 a = *(const f32x4*)cb, b4 = *(const f32x4*)(cb + 4); bias[0] = a.x; bias[1] = a.y; bias[2] = a.z; bias[3] = a.w; bias[4] = b4.x; bias[5] = b4.y; bias[6] = b4.z; bias[7] = b4.w; }
        const int tp0 = 64 * c + strip * 8 - 48;
        v4u rawr[11];
#pragma unroll
        for (int rr = 0; rr < 11; ++rr) { const int tp = tp0 - 3 + rr; rawr[rr] = tp >= 0 ? *(const v4u*)(PROJ + (size_t)row_of_tp(b, tp) * NPROJ + C_SSX + ch) : (v4u){0u, 0u, 0u, 0u}; }
        float win[3][8];
#pragma unroll
        for (int rr = 0; rr < 3; ++rr) unpack8(rawr[rr], win[rr]);
#pragma unroll
        for (int tt = 0; tt < 8; ++tt) {
            const int tp = tp0 + tt; float cur[8]; unpack8(rawr[3 + tt], cur);
            float o[8];
#pragma unroll
            for (int e = 0; e < 8; ++e) { const float a = bias[e] + w[0][e] * win[0][e] + w[1][e] * win[1][e] + w[2][e] * win[2][e] + w[3][e] * cur[e]; o[e] = (tp >= 0) ? siluf(a) : 0.f;
                win[0][e] = win[1][e]; win[1][e] = win[2][e]; win[2][e] = cur[e]; }
            const int trow = strip * 8 + tt;
            if (part == 0) { *(LAS f32x4*)(XS + trow * 128 + cgi * 8) = (f32x4){o[0], o[1], o[2], o[3]}; *(LAS f32x4*)(XS + trow * 128 + cgi * 8 + 4) = (f32x4){o[4], o[5], o[6], o[7]}; }
            else *(LAS v4u*)(lds + (part == 1 ? L_B : L_C) + swz(trow, cgi * 16, 256)) = pack8(o);
        }
        if (c == NCHUNK - 1 && strip == 7) {
            float* o = F.out + O_SSMCP + (size_t)((l * 2 + b) * 3) * 768 + ch;
#pragma unroll
            for (int j = 0; j < 3; ++j) { *(f32x4*)(o + j * 768) = (f32x4){win[j][0], win[j][1], win[j][2], win[j][3]}; *(f32x4*)(o + j * 768 + 4) = (f32x4){win[j][4], win[j][5], win[j][6], win[j][7]}; }
        }
    } else if (tid >= 448) {
        const int tp = 64 * c + lane - 48;
#pragma unroll
        for (int hh = 0; hh < 2; ++hh) { const int h = 2 * g + hh; float dt = 0.f;
            if (tp >= 0) dt = softplusf_(((const float*)(F.ws + WS_SMALL))[(size_t)row_of_tp(b, tp) * 16 + 8 + h] + F.in[I_SSDTB][l * 4 + h]);
            const float a = -__expf(F.in[I_SSALOG][l * 4 + h]) * dt;
            const float gc = wave_incl_scan(a, lane); const float g63 = lane_bcast(gc, 63);
            DT[hh * 64 + lane] = dt; GC[hh * 64 + lane] = gc; EG[hh * 64 + lane] = __expf(gc); EGL[hh * 64 + lane] = __expf(g63 - gc);
            if (lane == 0) ((float*)(F.ws + WS_SSGL))[(b * 4 + h) * 132 + c] = __expf(g63); }
    }
    __syncthreads();
    {
        const int fr = lane & 15, fq = lane >> 4;
#pragma unroll
        for (int tq = 0; tq < 2; ++tq) { const int t = 2 * wave + tq, mi = t >> 2, nj = t & 3;
            if (nj <= mi) { f32x4 acc = {0.f, 0.f, 0.f, 0.f};
#pragma unroll
                for (int kk = 0; kk < 4; ++kk) { const bf16x8 x = *(const LAS bf16x8*)(lds + L_B + swz(16 * nj + fr, 64 * kk + 16 * fq, 256)); const bf16x8 y = *(const LAS bf16x8*)(lds + L_C + swz(16 * mi + fr, 64 * kk + 16 * fq, 256)); acc = mma16(x, y, acc); }
                *(LAS f32x4*)(CB + (16 * mi + fr) * 64 + 16 * nj + 4 * fq) = acc; } }
        const int hh = tid >> 8, p = (tid & 255) >> 2, tq4 = tid & 3;
#pragma unroll
        for (int t0 = 0; t0 < 16; t0 += 8) { float v[8];
#pragma unroll
            for (int k = 0; k < 8; ++k) { const int t = 16 * tq4 + t0 + k; v[k] = XS[t * 128 + hh * 64 + p] * DT[hh * 64 + t]; }
            *(LAS v4u*)(lds + L_XDTT + hh * 8192 + swz(p, 2 * (16 * tq4 + t0), 128)) = pack8(v); }
        { const int t256 = tid & 255, s = t256 >> 1, th = t256 & 1;
#pragma unroll
            for (int i0 = 0; i0 < 32; i0 += 8) { float v[8];
#pragma unroll
                for (int k = 0; k < 8; ++k) { const int i = 32 * th + i0 + k; v[k] = bf2f(*(const LAS unsigned short*)(lds + L_B + swz(i, 2 * s, 256))) * EGL[hh * 64 + i]; }
                *(LAS v4u*)(lds + L_BDT + hh * 16384 + swz(s, 2 * (32 * th + i0), 128)) = pack8(v); } }
    }
    __syncthreads();
    {
        const int hh = tid >> 8, i = (tid & 255) >> 2, jq = tid & 3; const float gci = GC[hh * 64 + i];
#pragma unroll
        for (int j0 = 0; j0 < 16; j0 += 8) { float v[8];
#pragma unroll
            for (int k = 0; k < 8; ++k) { const int j = 16 * jq + j0 + k; v[k] = (j <= i) ? CB[i * 64 + j] * __expf(gci - GC[hh * 64 + j]) : 0.f; }
            *(LAS v4u*)(lds + L_ATT + hh * 8192 + swz(i, 2 * (16 * jq + j0), 128)) = pack8(v); }
    }
    __syncthreads();
    {
        const int fr = lane & 15, fq = lane >> 4;
        const int hh = wave >> 2, mi = wave & 3, h = 2 * g + hh;
        unsigned char* rec = ssmrec_ptr(F.ws, b, c, h);
        const float Dh = F.in[I_SSD][l * 4 + h];
        const int i = 16 * mi + fr;
#pragma unroll
        for (int pt = 0; pt < 4; ++pt) { f32x4 acc = {0.f, 0.f, 0.f, 0.f};
#pragma unroll
            for (int kk = 0; kk < 2; ++kk) { const bf16x8 x = *(const LAS bf16x8*)(lds + L_XDTT + hh * 8192 + swz(16 * pt + fr, 64 * kk + 16 * fq, 128)); const bf16x8 y = *(const LAS bf16x8*)(lds + L_ATT + hh * 8192 + swz(i, 64 * kk + 16 * fq, 128)); acc = mma16(x, y, acc); }
            const f32x4 xv = *(const LAS f32x4*)(XS + i * 128 + hh * 64 + 16 * pt + 4 * fq);
            *(u32x2*)(rec + S_YIN + swz(i, 2 * (16 * pt + 4 * fq), 128)) = pack4(acc[0] + xv.x * Dh, acc[1] + xv.y * Dh, acc[2] + xv.z * Dh, acc[3] + xv.w * Dh); }
    }
    {
        const int fr = lane & 15, fq = lane >> 4, hh = wave >> 2, pt = wave & 3, h = 2 * g + hh;
        unsigned char* rec = ssmrec_ptr(F.ws, b, c, h);
        bf16x8 xf[2];
#pragma unroll
        for (int kk = 0; kk < 2; ++kk) xf[kk] = *(const LAS bf16x8*)(lds + L_XDTT + hh * 8192 + swz(16 * pt + fr, 64 * kk + 16 * fq, 128));
#pragma unroll
        for (int st = 0; st < 8; ++st) { f32x4 acc = {0.f, 0.f, 0.f, 0.f};
#pragma unroll
            for (int kk = 0; kk < 2; ++kk) acc = mma16(*(const LAS bf16x8*)(lds + L_BDT + hh * 16384 + swz(16 * st + fr, 64 * kk + 16 * fq, 128)), xf[kk], acc);
            *(u32x2*)(rec + S_DH + swz(16 * pt + fr, 2 * (16 * st + 4 * fq), 256)) = pack4(acc[0], acc[1], acc[2], acc[3]); }
    }
    {
        const int hh = tid >> 8, h = 2 * g + hh, t = tid & 255;
        unsigned char* rec = ssmrec_ptr(F.ws, b, c, h);
        const int i = t >> 2, q4 = t & 3; const float e = EG[hh * 64 + i];
#pragma unroll
        for (int cchunk = 0; cchunk < 4; ++cchunk) { const int kb = (q4 * 4 + cchunk) * 16; float v[8]; unpack8(*(const LAS v4u*)(lds + L_C + swz(i, kb, 256)), v);
#pragma unroll
            for (int k = 0; k < 8; ++k) v[k] *= e;
            *(v4u*)(rec + S_CD + swz(i, kb, 256)) = pack8(v); }
    }
    __syncthreads();
}
#ifndef PROBE_M1
#define PROBE_M1 0
#endif
__device__ __forceinline__ void phase_m1(Frame& F, int l) {
    constexpr int NDN = 2 * NCHUNK * 4, NSS = 2 * NCHUNK * 2;
    const unsigned long long t0 = PROBE_M1 ? __builtin_amdgcn_s_memrealtime() : 0ull;
#pragma unroll 1
    for (int u = F.vcu; u < NDN; u += F.G) { const int b = u / (NCHUNK * 4), rem = u % (NCHUNK * 4); dn1_unit(F, l, b, rem >> 2, rem & 3); }
    const unsigned long long t1 = PROBE_M1 ? __builtin_amdgcn_s_memrealtime() : 0ull;
    if (PROBE_M1 == 1) { const unsigned long long te = t1 + 4 * (t1 - t0); while (__builtin_amdgcn_s_memrealtime() < te) __builtin_amdgcn_s_sleep(8); }
#pragma unroll 1
    for (int v = (F.vcu + F.G - 8) % F.G; v < NSS; v += F.G) { const int b = v / (NCHUNK * 2), rem = v % (NCHUNK * 2); ssm1_unit(F, l, b, rem >> 1, rem & 1); }
    if (PROBE_M1 == 2) { const unsigned long long t2 = __builtin_amdgcn_s_memrealtime(); const unsigned long long te = t2 + 4 * (t2 - t1); while (__builtin_amdgcn_s_memrealtime() < te) __builtin_amdgcn_s_sleep(8); }
}


__device__ __forceinline__ void dma1k(const unsigned char* gsrc, LAS unsigned char* ldst, int lane) {
    __builtin_amdgcn_global_load_lds((const unsigned*)(gsrc + lane * 16), (LAS unsigned*)ldst, 16, 0, 0);
}
__device__ __forceinline__ void dn_chain(Frame& F, int l, int b, int h, int s) {
    LAS unsigned char* lds = F.lds;
    constexpr int L_ST = 0, L_GL = 2 * 8192, DCH = 4;
    int tid = F.tid; asm volatile("" : "+v"(tid)); const int lane = tid & 63, wave = __builtin_amdgcn_readfirstlane(tid >> 6), fr = lane & 15, fq = lane >> 4;
    for (int i = tid; i < 8192 / 16; i += NTHREADS) *(LAS v4u*)(lds + L_ST + i * 16) = (v4u){0u, 0u, 0u, 0u};
    if (tid < NCHUNK) ((LAS float*)(lds + L_GL))[tid] = ((const float*)(F.ws + WS_DNGL))[(b * 4 + h) * 132 + tid];
    f32x4 acc[2] = {{0.f, 0.f, 0.f, 0.f}, {0.f, 0.f, 0.f, 0.f}};
    bf16x8 pf[DCH][4]; u32x2 rt[DCH][2];
    const int stoff0 = swz(fr, 2 * (16 * wave + 4 * fq), 256), stoff1 = swz(16 + fr, 2 * (16 * wave + 4 * fq), 256);
    const unsigned gst0 = ((((s * 2 + 0) * 8 + wave) * 16 + fr) * 4 + fq) * 8, gst1 = ((((s * 2 + 1) * 8 + wave) * 16 + fr) * 4 + fq) * 8;
    const unsigned poff = R_P + (wave * 4 * 64 + lane) * 16, roff = R_RT + ((s * 8 + wave) * 2 * 64 + lane) * 8;
#define DC_LOAD(slot, cidx) do { const unsigned char* rec_ = dnrec_ptr(F.ws, b, (cidx), h); \
        _Pragma("unroll") for (int kk_ = 0; kk_ < 4; ++kk_) pf[slot][kk_] = *(const bf16x8*)(rec_ + (size_t)(poff + kk_ * 1024)); \
        rt[slot][0] = *(const u32x2*)(rec_ + (size_t)roff); rt[slot][1] = *(const u32x2*)(rec_ + (size_t)(roff + 512)); } while (0)
#pragma unroll
    for (int k = 0; k < DCH; ++k) DC_LOAD(k, k);
    u32x2 sv0 = {0u, 0u}, sv1 = {0u, 0u};
#define DC_STEP(k_, c_) do { \
        BAR_LDS(); \
        LAS unsigned char* STc = lds + L_ST + ((c_) & 1) * 8192; LAS unsigned char* STn = lds + L_ST + (((c_) + 1) & 1) * 8192; \
        { unsigned char* st; { const unsigned long long sa_ = (unsigned long long)dnst_ptr(F.ws, b, (c_), h); \
              st = (unsigned char*)(((unsigned long long)(unsigned)__builtin_amdgcn_readfirstlane((int)(sa_ >> 32)) << 32) | (unsigned)__builtin_amdgcn_readfirstlane((int)sa_)); } \
          asm volatile("s_nop 4\n\tglobal_store_dwordx2 %0, %1, %2\n\ts_nop 1" :: "v"(gst0), "v"(sv0), "s"(st) : "memory"); \
          asm volatile("s_nop 4\n\tglobal_store_dwordx2 %0, %1, %2\n\ts_nop 1" :: "v"(gst1), "v"(sv1), "s"(st) : "memory"); } \
        const float gl = ((const LAS float*)(lds + L_GL))[(c_)]; \
        _Pragma("unroll") for (int n2 = 0; n2 < 2; ++n2) { const u32x2 r = rt[k_][n2]; acc[n2] = acc[n2] * gl + (f32x4){bflo(r.x), bfhi(r.x), bflo(r.y), bfhi(r.y)}; } \
        bf16x8 sf_[4][2]; \
        _Pragma("unroll") for (int kk = 0; kk < 4; ++kk) \
            _Pragma("unroll") for (int n2 = 0; n2 < 2; ++n2) sf_[kk][n2] = *(const LAS bf16x8*)(STc + swz(16 * n2 + fr, 64 * kk + 16 * fq, 256)); \
        asm volatile("s_waitcnt lgkmcnt(0)" ::: "memory"); __builtin_amdgcn_sched_barrier(0); \
        _Pragma("unroll") for (int kk = 0; kk < 4; ++kk) \
            _Pragma("unroll") for (int n2 = 0; n2 < 2; ++n2) acc[n2] = mma16(pf[k_][kk], sf_[kk][n2], acc[n2]); \
        sv0 = pack4(acc[0][0], acc[0][1], acc[0][2], acc[0][3]); sv1 = pack4(acc[1][0], acc[1][1], acc[1][2], acc[1][3]); \
        *(LAS u32x2*)(STn + stoff0) = sv0; *(LAS u32x2*)(STn + stoff1) = sv1; \
        { const int cn_ = (c_) + DCH < NCHUNK ? (c_) + DCH : NCHUNK - 1; DC_LOAD(k_, cn_); } } while (0)
    constexpr int TRIP = 4 * DCH, NTRIP = NCHUNK / TRIP;
#pragma unroll 1
    for (int c0 = 0; c0 < NTRIP * TRIP; c0 += TRIP) {
#pragma unroll
        for (int k = 0; k < TRIP; ++k) DC_STEP(k % DCH, c0 + k);
    }
#pragma unroll
    for (int j = 0; j < NCHUNK - NTRIP * TRIP; ++j) DC_STEP(j % DCH, NTRIP * TRIP + j);
#undef DC_STEP
#undef DC_LOAD
    float* o = F.out + O_DNP + (size_t)((l * 2 + b) * 4 + h) * 128 * 128;
#pragma unroll
    for (int n2 = 0; n2 < 2; ++n2)
#pragma unroll
        for (int r = 0; r < 4; ++r) o[(size_t)(16 * wave + 4 * fq + r) * 128 + 32 * s + 16 * n2 + fr] = acc[n2][r];
    asm volatile("s_waitcnt vmcnt(0)" ::: "memory");
    __syncthreads();
}
__device__ __forceinline__ void ssm_chain(Frame& F, int l, int b, int h) {
    LAS unsigned char* lds = F.lds;
    int tid = F.tid; asm volatile("" : "+v"(tid));
    if (tid < NCHUNK) ((LAS float*)lds)[tid] = ((const float*)(F.ws + WS_SSGL))[(b * 4 + h) * 132 + tid];
    __syncthreads();
    float hr[16];
#pragma unroll
    for (int i = 0; i < 16; ++i) hr[i] = 0.f;
    const int o = tid * 32;
    v4u ring[4][2];
#pragma unroll
    for (int k = 0; k < 4; ++k) { const unsigned char* rec = ssmrec_ptr(F.ws, b, k, h) + S_DH + o; ring[k][0] = *(const v4u*)rec; ring[k][1] = *(const v4u*)(rec + 16); }
#pragma unroll 1
    for (int c0 = 0; c0 < NCHUNK; c0 += 4) {
#pragma unroll
        for (int k = 0; k < 4; ++k) { const int c = c0 + k;
            if (c < NCHUNK) {
                unsigned char* st = ssmst_ptr(F.ws, b, c, h) + o;
                *(v4u*)st = pack8(&hr[0]); *(v4u*)(st + 16) = pack8(&hr[8]);
                const float gl = ((const LAS float*)lds)[c]; float d[16]; unpack8(ring[k][0], &d[0]); unpack8(ring[k][1], &d[8]);
#pragma unroll
                for (int i = 0; i < 16; ++i) hr[i] = hr[i] * gl + d[i];
                if (c + 4 < NCHUNK) { const unsigned char* rec = ssmrec_ptr(F.ws, b, c + 4, h) + S_DH + o; ring[k][0] = *(const v4u*)rec; ring[k][1] = *(const v4u*)(rec + 16); }
            } }
    }
    { const int p = o >> 8, cs = (o & 255) >> 4; float* out = F.out + O_SSMP + (size_t)((l * 2 + b) * 4 + h) * 64 * 128 + (size_t)p * 128;
#pragma unroll
      for (int j = 0; j < 2; ++j) { const int s0 = ((cs + j) ^ (p & 7)) * 8;
        *(f32x4*)(out + s0) = (f32x4){hr[8 * j], hr[8 * j + 1], hr[8 * j + 2], hr[8 * j + 3]}; *(f32x4*)(out + s0 + 4) = (f32x4){hr[8 * j + 4], hr[8 * j + 5], hr[8 * j + 6], hr[8 * j + 7]}; } }
    __syncthreads();
}

__device__ __forceinline__ float rope_inv(int j) { return exp2f(-(float)j * 0.4152410118609203f); }

__device__ __forceinline__ void swa_unit(Frame& F, int l, int b, int n, int kvh) {
    LAS unsigned char* lds = F.lds;
    constexpr int L_Q = 0, L_K = 36864, L_VT = 73728;
    int tid = F.tid; asm volatile("" : "+v"(tid)); const int lane = tid & 63, wave = __builtin_amdgcn_readfirstlane(tid >> 6), fr = lane & 15, fq = lane >> 4;
    const bf16* PROJ = (const bf16*)(F.ws + WS_PROJ); bf16* MIXED = (bf16*)(F.ws + WS_MIXED);
#pragma unroll
    for (int it = 0; it < 4; ++it) {
        const int id = tid + 512 * (it & 1), r = id >> 2, jj = id & 3; const bool isq = it < 2;
        const int p = isq ? 128 * n + (r & 127) : 128 * (n - 1) + r; const bool ok = p >= 112;
        float o1[8], o2[8];
        if (ok) { const int row = row_of_tp(b, p - 112); const int col = isq ? C_SWQ + (2 * kvh + (r >> 7)) * 64 : C_SWK + kvh * 64;
            float x1[8], x2[8]; unpack8(*(const v4u*)(PROJ + (size_t)row * NPROJ + col + 8 * jj), x1); unpack8(*(const v4u*)(PROJ + (size_t)row * NPROJ + col + 32 + 8 * jj), x2);
            const float pos = (float)(p - 112);
#pragma unroll
            for (int e = 0; e < 8; ++e) { float sn, cs; sincosf(pos * rope_inv(8 * jj + e), &sn, &cs); o1[e] = x1[e] * cs - x2[e] * sn; o2[e] = x2[e] * cs + x1[e] * sn; }
            if (!isq && n == NSWAB - 1 && r >= 128) { float* ko = F.out + O_KP + (size_t)(((l * 2 + b) * 128 + (r - 128)) * 2 + kvh) * 64;
                *(f32x4*)(ko + 8 * jj) = (f32x4){o1[0], o1[1], o1[2], o1[3]}; *(f32x4*)(ko + 8 * jj + 4) = (f32x4){o1[4], o1[5], o1[6], o1[7]};
                *(f32x4*)(ko + 32 + 8 * jj) = (f32x4){o2[0], o2[1], o2[2], o2[3]}; *(f32x4*)(ko + 32 + 8 * jj + 4) = (f32x4){o2[4], o2[5], o2[6], o2[7]}; }
        } else {
#pragma unroll
            for (int e = 0; e < 8; ++e) { o1[e] = 0.f; o2[e] = 0.f; } }
        LAS unsigned char* dst = lds + (isq ? L_Q : L_K) + r * 144;
        *(LAS v4u*)(dst + 16 * jj) = pack8(o1); *(LAS v4u*)(dst + 64 + 16 * jj) = pack8(o2);
    }
#pragma unroll
    for (int it = 0; it < 4; ++it) {
        const int id = tid + 512 * it, r = id >> 3, dc = id & 7; const int p = 128 * (n - 1) + r; float v[8];
        if (p >= 112) { const int row = row_of_tp(b, p - 112); unpack8(*(const v4u*)(PROJ + (size_t)row * NPROJ + C_SWV + kvh * 64 + 8 * dc), v);
            if (n == NSWAB - 1 && r >= 128) { float* vo = F.out + O_VP + (size_t)(((l * 2 + b) * 128 + (r - 128)) * 2 + kvh) * 64 + 8 * dc;
                *(f32x4*)vo = (f32x4){v[0], v[1], v[2], v[3]}; *(f32x4*)(vo + 4) = (f32x4){v[4], v[5], v[6], v[7]}; }
        } else {
#pragma unroll
            for (int e = 0; e < 8; ++e) v[e] = 0.f; }
#pragma unroll
        for (int e = 0; e < 8; ++e) *(LAS unsigned short*)(lds + L_VT + (8 * dc + e) * 528 + 2 * r) = (unsigned short)f2bf(v[e]);
    }
    __syncthreads();
    const int hh = wave >> 2, w4 = wave & 3, hq = 2 * kvh + hh;
    const float sink = F.in[I_SINK][l * 4 + hq];
    f32x4 sc[2][10];
#pragma unroll
    for (int rt = 0; rt < 2; ++rt) {
        bf16x8 qf[2];
#pragma unroll
        for (int kk = 0; kk < 2; ++kk) qf[kk] = *(const LAS bf16x8*)(lds + L_Q + (hh * 128 + 32 * w4 + 16 * rt + fr) * 144 + 64 * kk + 16 * fq);
#pragma unroll
        for (int kt = 0; kt < 10; ++kt) { f32x4 a = {0.f, 0.f, 0.f, 0.f};
#pragma unroll
            for (int kk = 0; kk < 2; ++kk) { const bf16x8 kf = *(const LAS bf16x8*)(lds + L_K + (16 * (2 * w4 + kt) + fr) * 144 + 64 * kk + 16 * fq); a = mma16(kf, qf[kk], a); }
            sc[rt][kt] = a; }
    }
    float linv[2];
#pragma unroll
    for (int rt = 0; rt < 2; ++rt) {
        const int i = 32 * w4 + 16 * rt + fr; float m = -1e30f;
#pragma unroll
        for (int kt = 0; kt < 10; ++kt)
#pragma unroll
            for (int r = 0; r < 4; ++r) { const int kj = 16 * (2 * w4 + kt) + 4 * fq + r, rel = i + 128 - kj; const bool ok = rel >= 0 && rel < 128 && (128 * (n - 1) + kj >= 112);
                const float s = ok ? sc[rt][kt][r] * 0.125f : -1e30f; sc[rt][kt][r] = s; m = fmaxf(m, s); }
        m = fmaxf(m, __shfl_xor(m, 16)); m = fmaxf(m, __shfl_xor(m, 32)); m = fmaxf(m, sink);
        float sum = 0.f;
#pragma unroll
        for (int kt = 0; kt < 10; ++kt)
#pragma unroll
            for (int r = 0; r < 4; ++r) { const float s = sc[rt][kt][r]; const float pv = s > -1e29f ? __expf(s - m) : 0.f; sc[rt][kt][r] = pv; sum += pv; }
        sum += __shfl_xor(sum, 16); sum += __shfl_xor(sum, 32); sum += __expf(sink - m);
        linv[rt] = 1.f / sum;
    }
    f32x4 ao[2][4];
#pragma unroll
    for (int rt = 0; rt < 2; ++rt)
#pragma unroll
        for (int dt = 0; dt < 4; ++dt) ao[rt][dt] = (f32x4){0.f, 0.f, 0.f, 0.f};
#pragma unroll
    for (int ks = 0; ks < 5; ++ks) {
        bf16x8 pf[2];
#pragma unroll
        for (int rt = 0; rt < 2; ++rt) { const v4u t = {pk2(sc[rt][2 * ks][0], sc[rt][2 * ks][1]), pk2(sc[rt][2 * ks][2], sc[rt][2 * ks][3]), pk2(sc[rt][2 * ks + 1][0], sc[rt][2 * ks + 1][1]), pk2(sc[rt][2 * ks + 1][2], sc[rt][2 * ks + 1][3])};
            pf[rt] = __builtin_bit_cast(bf16x8, t); }
#pragma unroll
        for (int dt = 0; dt < 4; ++dt) {
            const int kb = 16 * (2 * w4 + 2 * ks) + 4 * fq;
            const u32x2 v0 = *(const LAS u32x2*)(lds + L_VT + (16 * dt + fr) * 528 + 2 * kb), v1 = *(const LAS u32x2*)(lds + L_VT + (16 * dt + fr) * 528 + 2 * (kb + 16));
            const v4u t = {v0.x, v0.y, v1.x, v1.y}; const bf16x8 vf = __builtin_bit_cast(bf16x8, t);
#pragma unroll
            for (int rt = 0; rt < 2; ++rt) ao[rt][dt] = mma16(vf, pf[rt], ao[rt][dt]);
        }
    }
#pragma unroll
    for (int rt = 0; rt < 2; ++rt) { const int p = 128 * n + 32 * w4 + 16 * rt + fr;
        if (p >= 112) { bf16* o = MIXED + (size_t)row_of_tp(b, p - 112) * D + 768 + hq * 64 + 4 * fq;
#pragma unroll
            for (int dt = 0; dt < 4; ++dt) *(u32x2*)(o + 16 * dt) = pack4(ao[rt][dt][0] * linv[rt], ao[rt][dt][1] * linv[rt], ao[rt][dt][2] * linv[rt], ao[rt][dt][3] * linv[rt]); } }
    __syncthreads();
}


__device__ __forceinline__ void sdn_unit(Frame& F, int l, int sb) {
    LAS unsigned char* lds = F.lds;
    constexpr int L_CV = 0, L_OS = 49152, L_BETA = 65536, L_AT = 65664;
    int tid = F.tid; asm volatile("" : "+v"(tid)); const int lane = tid & 63, wave = __builtin_amdgcn_readfirstlane(tid >> 6);
    const bf16* PROJ = (const bf16*)(F.ws + WS_PROJ); bf16* MIXED = (bf16*)(F.ws + WS_MIXED);
    LAS float* CV = (LAS float*)(lds + L_CV); LAS float* OS = (LAS float*)(lds + L_OS); LAS float* BETA = (LAS float*)(lds + L_BETA); LAS float* AT = (LAS float*)(lds + L_AT);
    const int row0 = R_SAMPLE + sb * 8;
#pragma unroll
    for (int k = 0; k < 3; ++k) { const int ch = tid + 512 * k;
        float raw[11];
#pragma unroll
        for (int j = 0; j < 3; ++j) raw[j] = F.in[I_SDNC][((size_t)(l * DECB + sb) * 3 + j) * 1536 + ch];
#pragma unroll
        for (int t = 0; t < 8; ++t) raw[3 + t] = bf2f(PROJ[(size_t)(row0 + t) * NPROJ + ch]);
        float w[4];
#pragma unroll
        for (int i = 0; i < 4; ++i) w[i] = F.in[I_DNCW][(size_t)(l * 4 + i) * 1536 + ch];
#pragma unroll
        for (int t = 0; t < 8; ++t) CV[t * 1536 + ch] = siluf(w[0] * raw[t] + w[1] * raw[t + 1] + w[2] * raw[t + 2] + w[3] * raw[t + 3]);
#pragma unroll
        for (int j = 0; j < 3; ++j) F.out[O_DNCS + ((size_t)(l * DECB + sb) * 3 + j) * 1536 + ch] = raw[8 + j];
    }
    if (tid < 32) { const int t = tid >> 2, h = tid & 3; const float* sm = (const float*)(F.ws + WS_SMALL) + (size_t)(row0 + t) * 16;
        BETA[tid] = sigmoidf_(sm[h]); AT[tid] = __expf(-__expf(F.in[I_DNALOG][l * 4 + h]) * softplusf_(sm[4 + h] + F.in[I_DNDTB][l * 4 + h])); }
    __syncthreads();
    {
        const int t = wave;
#pragma unroll
        for (int v = 0; v < 8; ++v) { LAS float* p = CV + t * 1536 + v * 128; const float a = p[lane], b2 = p[lane + 64]; const float ss = wave_sum(a * a + b2 * b2);
            const float rn = rsqrtf(ss + EPS) * (v < 4 ? 0.08838834764831845f : 1.f); p[lane] = a * rn; p[lane + 64] = b2 * rn; }
    }
    __syncthreads();
    {
        const int h = tid >> 7, col = tid & 127;
        float S[128];
        const float* s0 = F.in[I_SDN] + ((size_t)(l * DECB + sb) * 4 + h) * 128 * 128 + col;
#pragma unroll
        for (int i0 = 0; i0 < 128; i0 += 8) {
#pragma unroll
            for (int i = 0; i < 8; ++i) S[i0 + i] = s0[i * 128];
            s0 += 8 * 128; asm volatile("" : "+v"(s0)); }
#pragma unroll 1
        for (int t = 0; t < 8; ++t) {
            const LAS float* q = CV + t * 1536 + h * 128; const LAS float* k = CV + t * 1536 + 512 + h * 128;
            const float a = AT[t * 4 + h], bt = BETA[t * 4 + h], vc = CV[t * 1536 + 1024 + h * 128 + col];
            float ks = 0.f;
#pragma unroll
            for (int i4 = 0; i4 < 32; ++i4) { const f32x4 kv = *(const LAS f32x4*)(k + 4 * i4); ks += (kv.x * S[4 * i4] + kv.y * S[4 * i4 + 1]) + (kv.z * S[4 * i4 + 2] + kv.w * S[4 * i4 + 3]);
                if ((i4 & 3) == 3) asm volatile("" : "+v"(ks) :: "memory"); }
            const float coef = bt * (vc - a * ks); float o = 0.f;
#pragma unroll
            for (int i4 = 0; i4 < 32; ++i4) { const f32x4 kv = *(const LAS f32x4*)(k + 4 * i4); const f32x4 qv = *(const LAS f32x4*)(q + 4 * i4);
                S[4 * i4] = a * S[4 * i4] + coef * kv.x; S[4 * i4 + 1] = a * S[4 * i4 + 1] + coef * kv.y; S[4 * i4 + 2] = a * S[4 * i4 + 2] + coef * kv.z; S[4 * i4 + 3] = a * S[4 * i4 + 3] + coef * kv.w;
                o += (qv.x * S[4 * i4] + qv.y * S[4 * i4 + 1]) + (qv.z * S[4 * i4 + 2] + qv.w * S[4 * i4 + 3]);
                if ((i4 & 3) == 3) asm volatile("" : "+v"(o) :: "memory"); }
            OS[t * 512 + tid] = o;
        }
        float* so = F.out + O_DNS + ((size_t)(l * DECB + sb) * 4 + h) * 128 * 128 + col;
#pragma unroll
        for (int i0 = 0; i0 < 128; i0 += 8) {
#pragma unroll
            for (int i = 0; i < 8; ++i) so[i * 128] = S[i0 + i];
            so += 8 * 128; asm volatile("" : "+v"(so)); }
    }
    __syncthreads();
    {
        const int t = wave, row = row0 + t;
#pragma unroll
        for (int h = 0; h < 4; ++h) { const float a = OS[t * 512 + h * 128 + lane], b2 = OS[t * 512 + h * 128 + lane + 64]; const float rn = rsqrtf(wave_sum(a * a + b2 * b2) * (1.f / 128.f) + EPS);
            const float z0 = bf2f(PROJ[(size_t)row * NPROJ + C_DNZ + h * 128 + lane]), z1 = bf2f(PROJ[(size_t)row * NPROJ + C_DNZ + h * 128 + lane + 64]);
            MIXED[(size_t)row * D + h * 128 + lane] = (bf16)f2bf(a * rn * F.in[I_DNNW][l * 128 + lane] * siluf(z0));
            MIXED[(size_t)row * D + h * 128 + lane + 64] = (bf16)f2bf(b2 * rn * F.in[I_DNNW][l * 128 + lane + 64] * siluf(z1)); }
    }
    __syncthreads();
}
__device__ __forceinline__ void sssm_unit(Frame& F, int l, int sb) {
    LAS unsigned char* lds = F.lds;
    constexpr int L_CX = 0, L_YS = 24576, L_DT = 32768, L_DA = 32896;
    int tid = F.tid; asm volatile("" : "+v"(tid)); const int lane = tid & 63, wave = __builtin_amdgcn_readfirstlane(tid >> 6);
    const bf16* PROJ = (const bf16*)(F.ws + WS_PROJ); bf16* MIXED = (bf16*)(F.ws + WS_MIXED);
    LAS float* CX = (LAS float*)(lds + L_CX); LAS float* YS = (LAS float*)(lds + L_YS); LAS float* DTs = (LAS float*)(lds + L_DT); LAS float* DA = (LAS float*)(lds + L_DA);
    const int row0 = R_SAMPLE + sb * 8;
#pragma unroll
    for (int k = 0; k < 2; ++k) { const int ch = tid + 512 * k;
        if (ch < 768) {
            float raw[11];
#pragma unroll
            for (int j = 0; j < 3; ++j) raw[j] = F.in[I_SSSMC][((size_t)(l * DECB + sb) * 3 + j) * 768 + ch];
#pragma unroll
            for (int t = 0; t < 8; ++t) raw[3 + t] = bf2f(PROJ[(size_t)(row0 + t) * NPROJ + C_SSX + ch]);
            float w[4];
#pragma unroll
            for (int i = 0; i < 4; ++i) w[i] = F.in[I_SSCW][(size_t)(l * 4 + i) * 768 + ch];
            const float bias = F.in[I_SSCB][l * 768 + ch];
#pragma unroll
            for (int t = 0; t < 8; ++t) CX[t * 768 + ch] = siluf(bias + w[0] * raw[t] + w[1] * raw[t + 1] + w[2] * raw[t + 2] + w[3] * raw[t + 3]);
#pragma unroll
            for (int j = 0; j < 3; ++j) F.out[O_SSMCS + ((size_t)(l * DECB + sb) * 3 + j) * 768 + ch] = raw[8 + j];
        }
    }
    if (tid < 32) { const int t = tid >> 2, h = tid & 3; const float dt = softplusf_(((const float*)(F.ws + WS_SMALL))[(size_t)(row0 + t) * 16 + 8 + h] + F.in[I_SSDTB][l * 4 + h]);
        DTs[tid] = dt; DA[tid] = __expf(-__expf(F.in[I_SSALOG][l * 4 + h]) * dt); }
    __syncthreads();
    {
        const int h = tid >> 7, t128 = tid & 127, pq = t128 >> 5, s4 = t128 & 31, g = h >> 1;
        f32x4 hr[16];
        const float* h0 = F.in[I_SSSM] + ((size_t)(l * DECB + sb) * 4 + h) * 64 * 128 + (size_t)(pq * 16) * 128 + 4 * s4;
#pragma unroll
        for (int jj = 0; jj < 16; ++jj) hr[jj] = *(const f32x4*)(h0 + (size_t)jj * 128);
#pragma unroll 1
        for (int t = 0; t < 8; ++t) {
            const float da = DA[t * 4 + h], dtv = DTs[t * 4 + h];
            const f32x4 B4 = *(const LAS f32x4*)(CX + t * 768 + 256 + g * 128 + 4 * s4), C4 = *(const LAS f32x4*)(CX + t * 768 + 512 + g * 128 + 4 * s4);
#pragma unroll
            for (int jj = 0; jj < 16; ++jj) { const float xv = CX[t * 768 + h * 64 + pq * 16 + jj] * dtv;
                hr[jj] = hr[jj] * da + B4 * xv;
                float part = (hr[jj].x * C4.x + hr[jj].y * C4.y) + (hr[jj].z * C4.z + hr[jj].w * C4.w);
                part += __shfl_xor(part, 1); part += __shfl_xor(part, 2); part += __shfl_xor(part, 4); part += __shfl_xor(part, 8); part += __shfl_xor(part, 16);
                if (s4 == 0) YS[t * 256 + h * 64 + pq * 16 + jj] = part; }
        }
        float* ho = F.out + O_SSMS + ((size_t)(l * DECB + sb) * 4 + h) * 64 * 128 + (size_t)(pq * 16) * 128 + 4 * s4;
#pragma unroll
        for (int jj = 0; jj < 16; ++jj) *(f32x4*)(ho + (size_t)jj * 128) = hr[jj];
    }
    __syncthreads();
    {
        const int t = wave, row = row0 + t;
#pragma unroll
        for (int g = 0; g < 2; ++g) { float v[2];
#pragma unroll
            for (int e = 0; e < 2; ++e) { const int idx = g * 128 + lane + 64 * e, h = idx >> 6; const float z = bf2f(PROJ[(size_t)row * NPROJ + C_SSZ + idx]);
                v[e] = (YS[t * 256 + idx] + CX[t * 768 + idx] * F.in[I_SSD][l * 4 + h]) * siluf(z); }
            const float rn = rsqrtf(wave_sum(v[0] * v[0] + v[1] * v[1]) * (1.f / 128.f) + EPS);
#pragma unroll
            for (int e = 0; e < 2; ++e) { const int idx = g * 128 + lane + 64 * e; MIXED[(size_t)row * D + 512 + idx] = (bf16)f2bf(v[e] * rn * F.in[I_SSNW][l * 256 + idx]); } }
    }
    __syncthreads();
}
__device__ __forceinline__ void sswa_unit(Frame& F, int l, int sb) {
    LAS unsigned char* lds = F.lds;
    constexpr int L_KC = 0, L_VC = 39168, L_QS = 78336, L_SC = 86528;
    int tid = F.tid; asm volatile("" : "+v"(tid)); const int lane = tid & 63, wave = __builtin_amdgcn_readfirstlane(tid >> 6);
    const bf16* PROJ = (const bf16*)(F.ws + WS_PROJ); bf16* MIXED = (bf16*)(F.ws + WS_MIXED);
    LAS float* QS = (LAS float*)(lds + L_QS); LAS float* SC = (LAS float*)(lds + L_SC);
    const int row0 = R_SAMPLE + sb * 8;
    const float* kc = F.in[I_CK] + (size_t)(l * DECB + sb) * 128 * 128; const float* vc = F.in[I_CV] + (size_t)(l * DECB + sb) * 128 * 128;
    float* kso = F.out + O_KS + (size_t)(l * DECB + sb) * 128 * 128; float* vso = F.out + O_VS + (size_t)(l * DECB + sb) * 128 * 128;
#pragma unroll
    for (int it = 0; it < 8; ++it) { const int idx4 = tid + 512 * it, rowk = idx4 >> 4, c4 = idx4 & 15;
        const f32x4 kv = *(const f32x4*)(kc + (size_t)idx4 * 4), vv = *(const f32x4*)(vc + (size_t)idx4 * 4);
        *(LAS u32x2*)(lds + L_KC + rowk * 144 + c4 * 8) = pack4(kv.x, kv.y, kv.z, kv.w); *(LAS u32x2*)(lds + L_VC + rowk * 144 + c4 * 8) = pack4(vv.x, vv.y, vv.z, vv.w);
        if (rowk >= 16) { *(f32x4*)(kso + (size_t)(idx4 - 256) * 4) = kv; *(f32x4*)(vso + (size_t)(idx4 - 256) * 4) = vv; } }
    {
        const int t = tid >> 6, kvh = (tid >> 5) & 1, j = tid & 31; const bf16* pr = PROJ + (size_t)(row0 + t) * NPROJ;
        const float x1 = bf2f(pr[C_SWK + kvh * 64 + j]), x2 = bf2f(pr[C_SWK + kvh * 64 + 32 + j]);
        float sn, cs; sincosf((float)(SEQ + t) * rope_inv(j), &sn, &cs);
        const float o1 = x1 * cs - x2 * sn, o2 = x2 * cs + x1 * sn; const int rowk = (128 + t) * 2 + kvh;
        *(LAS unsigned short*)(lds + L_KC + rowk * 144 + 2 * j) = (unsigned short)f2bf(o1); *(LAS unsigned short*)(lds + L_KC + rowk * 144 + 2 * (j + 32)) = (unsigned short)f2bf(o2);
        kso[(size_t)((120 + t) * 2 + kvh) * 64 + j] = o1; kso[(size_t)((120 + t) * 2 + kvh) * 64 + 32 + j] = o2;
#pragma unroll
        for (int e = 0; e < 2; ++e) { const int d = j + 32 * e; const float v = bf2f(pr[C_SWV + kvh * 64 + d]);
            *(LAS unsigned short*)(lds + L_VC + rowk * 144 + 2 * d) = (unsigned short)f2bf(v); vso[(size_t)((120 + t) * 2 + kvh) * 64 + d] = v; }
#pragma unroll
        for (int e = 0; e < 2; ++e) { const int hq = 2 * kvh + e;
            const float q1 = bf2f(pr[C_SWQ + hq * 64 + j]), q2 = bf2f(pr[C_SWQ + hq * 64 + 32 + j]);
            QS[(t * 4 + hq) * 64 + j] = q1 * cs - q2 * sn; QS[(t * 4 + hq) * 64 + 32 + j] = q2 * cs + q1 * sn; }
    }
    __syncthreads();
    if (tid < 272) {
        const int key = tid >> 1, kvh = tid & 1; float acc[16];
#pragma unroll
        for (int i = 0; i < 16; ++i) acc[i] = 0.f;
#pragma unroll
        for (int dc = 0; dc < 8; ++dc) { float kv[8]; unpack8(*(const LAS v4u*)(lds + L_KC + tid * 144 + dc * 16), kv);
#pragma unroll
            for (int t = 0; t < 8; ++t)
#pragma unroll
                for (int hh = 0; hh < 2; ++hh) { const LAS float* q = QS + (t * 4 + 2 * kvh + hh) * 64 + 8 * dc; const f32x4 qa = *(const LAS f32x4*)q, qb = *(const LAS f32x4*)(q + 4);
                    acc[t * 2 + hh] += (kv[0] * qa.x + kv[1] * qa.y) + (kv[2] * qa.z + kv[3] * qa.w) + (kv[4] * qb.x + kv[5] * qb.y) + (kv[6] * qb.z + kv[7] * qb.w); } }
#pragma unroll
        for (int t = 0; t < 8; ++t)
#pragma unroll
            for (int hh = 0; hh < 2; ++hh) SC[(t * 4 + 2 * kvh + hh) * 140 + key] = acc[t * 2 + hh] * 0.125f;
    }
    __syncthreads();
#pragma unroll
    for (int rr = 0; rr < 4; ++rr) { const int r = 4 * wave + rr, t = r >> 2, hq = r & 3; const float sink = F.in[I_SINK][l * 4 + hq];
        float s[3]; float m = -1e30f;
#pragma unroll
        for (int e = 0; e < 3; ++e) { const int key = lane + 64 * e; const bool ok = key < 136 && key >= t + 1 && key <= t + 128; s[e] = ok ? SC[r * 140 + key] : -1e30f; m = fmaxf(m, s[e]); }
        m = fmaxf(wave_max(m), sink); float sum = 0.f;
#pragma unroll
        for (int e = 0; e < 3; ++e) { s[e] = s[e] > -1e29f ? __expf(s[e] - m) : 0.f; sum += s[e]; }
        sum = wave_sum(sum) + __expf(sink - m); const float inv = 1.f / sum;
#pragma unroll
        for (int e = 0; e < 3; ++e) { const int key = lane + 64 * e; if (key < 136) SC[r * 140 + key] = s[e] * inv; } }
    __syncthreads();
    {
        const int r = tid >> 4, dq = tid & 15, t = r >> 2, hq = r & 3, kvh = hq >> 1; float o[4] = {0.f, 0.f, 0.f, 0.f};
        for (int key = 0; key < 136; ++key) { const float p = SC[r * 140 + key]; const u32x2 v = *(const LAS u32x2*)(lds + L_VC + (key * 2 + kvh) * 144 + dq * 8);
            o[0] += p * bflo(v.x); o[1] += p * bfhi(v.x); o[2] += p * bflo(v.y); o[3] += p * bfhi(v.y); }
        *(u32x2*)(MIXED + (size_t)(row0 + t) * D + 768 + hq * 64 + 4 * dq) = pack4(o[0], o[1], o[2], o[3]);
    }
    __syncthreads();
}
__device__ __forceinline__ void phase_m2(Frame& F, int l) {
    const int xg = F.vcu >> 5, xi = F.vcu & 31;
#ifndef PROBE_M2
#define PROBE_M2 0
#endif
#ifndef PROBE_REP
#define PROBE_REP 4
#endif
    if (xi < 4) { for (int rep_ = 0; rep_ < 1 + (PROBE_M2 & 1) * PROBE_REP; ++rep_) dn_chain(F, l, xg >> 2, xg & 3, xi); }
    else if (xi == 4) { for (int rep_ = 0; rep_ < 1 + ((PROBE_M2 >> 1) & 1) * PROBE_REP; ++rep_) ssm_chain(F, l, xg >> 2, xg & 3); }
    else {
      for (int rep = 0; rep < 1 + ((PROBE_M2 >> 2) & 1) * PROBE_REP; ++rep) {
        const int widx = xg * 27 + (xi - 5); constexpr int NW = 216, NSWA = 2 * NSWAB * 2;
        for (int u = widx; u < DECB + NSWA + DECB + DECB; u += NW) {
            if (u < DECB) sdn_unit(F, l, u);
            else if (u < DECB + NSWA) { const int v = u - DECB, b = v / (NSWAB * 2), rem = v % (NSWAB * 2); swa_unit(F, l, b, rem >> 1, rem & 1); }
            else if (u < DECB + NSWA + DECB) sssm_unit(F, l, u - DECB - NSWA);
            else sswa_unit(F, l, u - DECB - NSWA - DECB);
        }
      }
    }
}
__device__ __forceinline__ void dno_unit(Frame& F, int l, int b, int c, int h) {
    LAS unsigned char* lds = F.lds;
    constexpr int L_ST = 0, L_QP = 32768, L_RED = 49152;
    int tid = F.tid; asm volatile("" : "+v"(tid)); const int lane = tid & 63, wave = __builtin_amdgcn_readfirstlane(tid >> 6), fr = lane & 15, fq = lane >> 4;
    const bf16* PROJ = (const bf16*)(F.ws + WS_PROJ); bf16* MIXED = (bf16*)(F.ws + WS_MIXED);
    const unsigned char* rec = dnrec_ptr(F.ws, b, c, h); const unsigned char* st = dnst_ptr(F.ws, b, c, h);
#pragma unroll
    for (int i = 0; i < 2; ++i) { const int p = wave * 2 + i; dma1k(rec + R_QP + p * 1024, lds + L_QP + p * 1024, lane); }
    const int tt = wave & 3, ch = wave >> 2, t = 16 * tt + fr, tp = 64 * c + t - 48;
    f32x4 acc[4];
#pragma unroll
    for (int ct = 0; ct < 4; ++ct) { const u32x2 o0 = *(const u32x2*)(rec + R_O0 + (t * 128 + 16 * (4 * ch + ct) + 4 * fq) * 2); acc[ct] = (f32x4){bflo(o0.x), bfhi(o0.x), bflo(o0.y), bfhi(o0.y)}; }
    u32x2 zr[4];
    const size_t row = tp >= 0 ? (size_t)row_of_tp(b, tp) : 0;
#pragma unroll
    for (int ct = 0; ct < 4; ++ct) zr[ct] = *(const u32x2*)(PROJ + row * NPROJ + C_DNZ + h * 128 + 16 * (4 * ch + ct) + 4 * fq);
    bf16x8 sf[4][4];
#pragma unroll
    for (int ct = 0; ct < 4; ++ct) { const int coltile = 4 * ch + ct;
#pragma unroll
        for (int kk = 0; kk < 4; ++kk) sf[ct][kk] = *(const bf16x8*)(st + (((coltile * 8 + 2 * kk + (fq >> 1)) * 16 + fr) * 4 + 2 * (fq & 1)) * 8); }
    BAR_ALL();
#pragma unroll
    for (int kk = 0; kk < 4; ++kk) { const bf16x8 qf = *(const LAS bf16x8*)(lds + L_QP + swz(t, 64 * kk + 16 * fq, 256));
#pragma unroll
        for (int ct = 0; ct < 4; ++ct) acc[ct] = mma16(sf[ct][kk], qf, acc[ct]); }
    float ss = 0.f;
#pragma unroll
    for (int ct = 0; ct < 4; ++ct) ss += (acc[ct][0] * acc[ct][0] + acc[ct][1] * acc[ct][1]) + (acc[ct][2] * acc[ct][2] + acc[ct][3] * acc[ct][3]);
    ss += __shfl_xor(ss, 16); ss += __shfl_xor(ss, 32);
    if (fq == 0) ((LAS float*)(lds + L_RED))[t * 2 + ch] = ss;
    BAR_LDS();
    const float rn = rsqrtf((((const LAS float*)(lds + L_RED))[t * 2] + ((const LAS float*)(lds + L_RED))[t * 2 + 1]) * (1.f / 128.f) + EPS);
    if (tp >= 0) {
#pragma unroll
        for (int ct = 0; ct < 4; ++ct) { const int col = 16 * (4 * ch + ct) + 4 * fq; const f32x4 w = *(const f32x4*)(F.in[I_DNNW] + l * 128 + col);
            *(u32x2*)(MIXED + row * D + h * 128 + col) = pack4(acc[ct][0] * rn * w.x * siluf(bflo(zr[ct].x)), acc[ct][1] * rn * w.y * siluf(bfhi(zr[ct].x)), acc[ct][2] * rn * w.z * siluf(bflo(zr[ct].y)), acc[ct][3] * rn * w.w * siluf(bfhi(zr[ct].y))); } }
    __syncthreads();
}
__device__ __forceinline__ void ssmy_unit(Frame& F, int l, int b, int c, int g) {
    LAS unsigned char* lds = F.lds;
    constexpr int L_HS = 0, L_CD = 32768, L_RED = 65536;
    int tid = F.tid; asm volatile("" : "+v"(tid)); const int lane = tid & 63, wave = __builtin_amdgcn_readfirstlane(tid >> 6), fr = lane & 15, fq = lane >> 4;
    const bf16* PROJ = (const bf16*)(F.ws + WS_PROJ); bf16* MIXED = (bf16*)(F.ws + WS_MIXED);
#pragma unroll
    for (int i = 0; i < 8; ++i) { const int p = wave * 8 + i, hh = (p >> 4) & 1, q = p & 15;
        if (p < 32) dma1k(ssmst_ptr(F.ws, b, c, 2 * g + hh) + q * 1024, lds + L_HS + hh * 16384 + q * 1024, lane);
        else dma1k(ssmrec_ptr(F.ws, b, c, 2 * g + hh) + S_CD + q * 1024, lds + L_CD + hh * 16384 + q * 1024, lane); }
    const int hh = wave >> 2, tt = wave & 3, h = 2 * g + hh, t = 16 * tt + fr, tp = 64 * c + t - 48;
    const unsigned char* rec = ssmrec_ptr(F.ws, b, c, h);
    f32x4 acc[4];
#pragma unroll
    for (int pt = 0; pt < 4; ++pt) { const u32x2 y0 = *(const u32x2*)(rec + S_YIN + swz(t, 2 * (16 * pt + 4 * fq), 128)); acc[pt] = (f32x4){bflo(y0.x), bfhi(y0.x), bflo(y0.y), bfhi(y0.y)}; }
    u32x2 zr[4];
    const size_t row = tp >= 0 ? (size_t)row_of_tp(b, tp) : 0;
#pragma unroll
    for (int pt = 0; pt < 4; ++pt) zr[pt] = *(const u32x2*)(PROJ + row * NPROJ + C_SSZ + h * 64 + 16 * pt + 4 * fq);
    BAR_ALL();
#pragma unroll
    for (int kk = 0; kk < 4; ++kk) { const bf16x8 cf = *(const LAS bf16x8*)(lds + L_CD + hh * 16384 + swz(t, 64 * kk + 16 * fq, 256));
#pragma unroll
        for (int pt = 0; pt < 4; ++pt) acc[pt] = mma16(*(const LAS bf16x8*)(lds + L_HS + hh * 16384 + swz(16 * pt + fr, 64 * kk + 16 * fq, 256)), cf, acc[pt]); }
    float ss = 0.f;
#pragma unroll
    for (int pt = 0; pt < 4; ++pt) { acc[pt][0] *= siluf(bflo(zr[pt].x)); acc[pt][1] *= siluf(bfhi(zr[pt].x)); acc[pt][2] *= siluf(bflo(zr[pt].y)); acc[pt][3] *= siluf(bfhi(zr[pt].y));
        ss += (acc[pt][0] * acc[pt][0] + acc[pt][1] * acc[pt][1]) + (acc[pt][2] * acc[pt][2] + acc[pt][3] * acc[pt][3]); }
    ss += __shfl_xor(ss, 16); ss += __shfl_xor(ss, 32);
    if (fq == 0) ((LAS float*)(lds + L_RED))[t * 2 + hh] = ss;
    BAR_LDS();
    const float rn = rsqrtf((((const LAS float*)(lds + L_RED))[t * 2] + ((const LAS float*)(lds + L_RED))[t * 2 + 1]) * (1.f / 128.f) + EPS);
    if (tp >= 0) {
#pragma unroll
        for (int pt = 0; pt < 4; ++pt) { const int idx = h * 64 + 16 * pt + 4 * fq; const f32x4 w = *(const f32x4*)(F.in[I_SSNW] + l * 256 + idx);
            *(u32x2*)(MIXED + row * D + 512 + idx) = pack4(acc[pt][0] * rn * w.x, acc[pt][1] * rn * w.y, acc[pt][2] * rn * w.z, acc[pt][3] * rn * w.w); } }
    __syncthreads();
}
__device__ __forceinline__ void phase_m3(Frame& F, int l) {
    constexpr int NDN = 2 * NCHUNK * 4, NSS = 2 * NCHUNK * 2;
#pragma unroll 1
    for (int u = F.vcu; u < NDN; u += F.G) { const int b = u / (NCHUNK * 4), rem = u % (NCHUNK * 4); dno_unit(F, l, b, rem >> 2, rem & 3); }
#pragma unroll 1
    for (int v = (F.vcu + F.G - 8) % F.G; v < NSS; v += F.G) { const int b = v / (NCHUNK * 2), rem = v % (NCHUNK * 2); ssmy_unit(F, l, b, rem >> 1, rem & 1); }
    const int gw = F.vcu * NWAVES + F.wave, NGW = F.G * NWAVES;
    convert_weight(F, 1, l, gw, NGW); convert_weight(F, 2, l, gw, NGW); convert_weight(F, 3, l, gw, NGW);
    if (l == 0) convert_weight(F, 0, 1, gw, NGW);
    __syncthreads();
}

constexpr int N_PHASES = 19;
__global__ void __launch_bounds__(NTHREADS, 2) hybrid_fwd(Args args) {
    extern __shared__ __attribute__((aligned(16))) unsigned char lds_raw[];
    Frame F;
    F.lds = (LAS unsigned char*)lds_raw;
    F.tid = threadIdx.x; F.lane = F.tid & 63; F.wave = __builtin_amdgcn_readfirstlane(F.tid >> 6);
    const int wave0 = F.wave;
    F.G = gridDim.x; { const int bx = blockIdx.x; F.vcu = (F.G % 8 == 0) ? (bx % 8) * (F.G / 8) + bx / 8 : bx; }
    const int vcu0 = F.vcu;
    { KaPtr ka_ = (KaPtr)__builtin_amdgcn_kernarg_segment_ptr(); F.in.ka = ka_; F.out = ka_->out; F.ws = ka_->ws; }
    gu32* ctl = (gu32*)(F.ws + WS_CTL);
    for (int u = F.tid; u < (LDS_BYTES - LDSCTL_OFF) / 4; u += NTHREADS) ((LAS unsigned*)(F.lds + LDSCTL_OFF))[u] = 0u;
    __syncthreads();
    const int lo = args.ph_lo, hi = args.ph_hi;
    const bool multi = (hi - lo) > 1;
    XcdBarrier bar; bar.bar = (unsigned*)(ctl + CW_BAR); bar.x = 0; bar.st = nullptr;
    if (multi) bar = xcd_barrier_post((unsigned*)(ctl + CW_BAR), (volatile LAS unsigned*)(F.lds + LDSCTL_OFF + 32), F.tid);
    int bx_ = 0;
#define PH_BEGIN(phidx) if (lo <= (phidx) && (phidx) < hi) { const unsigned long long t0_ = PROBE_SPIN ? __builtin_amdgcn_s_memrealtime() : 0ull; (void)t0_; \
        { KaPtr ka_ = (KaPtr)__builtin_amdgcn_kernarg_segment_ptr(); int tid_ = (wave0 << 6) | (int)__builtin_amdgcn_mbcnt_hi(~0u, __builtin_amdgcn_mbcnt_lo(~0u, 0u)), vcu_ = vcu0, G_ = gridDim.x; bx_ = blockIdx.x; LAS unsigned char* lds_ = (LAS unsigned char*)lds_raw; \
          asm volatile("" : "+s"(ka_), "+v"(tid_), "+s"(vcu_), "+s"(G_), "+v"(lds_), "+s"(bx_)); \
          F.in.ka = ka_; F.out = ka_->out; F.ws = ka_->ws; F.tid = tid_; F.lane = tid_ & 63; F.wave = __builtin_amdgcn_readfirstlane(tid_ >> 6); F.vcu = vcu_; F.G = G_; F.lds = lds_; } \
        bf16* WIN = (bf16*)(F.ws + WS_WIN); bf16* WOUT = (bf16*)(F.ws + WS_WOUT); bf16* WFI = (bf16*)(F.ws + WS_WFI); bf16* WFO = (bf16*)(F.ws + WS_WFO); \
        bf16* XN = (bf16*)(F.ws + WS_XN); bf16* PROJ = (bf16*)(F.ws + WS_PROJ); bf16* MIXED = (bf16*)(F.ws + WS_MIXED); bf16* MOUT = (bf16*)(F.ws + WS_MOUT); bf16* ACT = (bf16*)(F.ws + WS_PROJ); \
        (void)WIN; (void)WOUT; (void)WFI; (void)WFO; (void)XN; (void)PROJ; (void)MIXED; (void)MOUT; (void)ACT;
#ifndef PROBE_SPIN
#define PROBE_SPIN 0
#endif
#ifndef PROBE_SPIN_K
#define PROBE_SPIN_K 4
#endif
#ifndef PROBE_SPIN_WHO
#define PROBE_SPIN_WHO 0
#endif
#define PH_SPIN(phidx) if (PROBE_SPIN && (((phidx) == 0) ? ((PROBE_SPIN >> 9) & 1) : ((PROBE_SPIN >> (((phidx) - 1) % 9)) & 1))) { \
        const int xi_ = vcu0 & 31; const bool who_ = PROBE_SPIN_WHO == 0 || (PROBE_SPIN_WHO == 1 && xi_ < 4) || (PROBE_SPIN_WHO == 2 && xi_ == 4) || (PROBE_SPIN_WHO == 3 && xi_ > 4); \
        if (who_) { const unsigned long long t1_ = __builtin_amdgcn_s_memrealtime(); const unsigned long long tend_ = t1_ + (unsigned long long)PROBE_SPIN_K * (t1_ - t0_); \
            while (__builtin_amdgcn_s_memrealtime() < tend_) __builtin_amdgcn_s_sleep(8); } }
#define RELAUNDER() do { KaPtr ka_ = (KaPtr)__builtin_amdgcn_kernarg_segment_ptr(); int tid_ = (wave0 << 6) | (int)__builtin_amdgcn_mbcnt_hi(~0u, __builtin_amdgcn_mbcnt_lo(~0u, 0u)), vcu_ = vcu0, G_ = gridDim.x; bx_ = blockIdx.x; LAS unsigned char* lds_ = (LAS unsigned char*)lds_raw; \
          asm volatile("" : "+s"(ka_), "+v"(tid_), "+s"(vcu_), "+s"(G_), "+v"(lds_), "+s"(bx_)); \
          F.in.ka = ka_; F.out = ka_->out; F.ws = ka_->ws; F.tid = tid_; F.lane = tid_ & 63; F.wave = __builtin_amdgcn_readfirstlane(tid_ >> 6); F.vcu = vcu_; F.G = G_; F.lds = lds_; \
          WOUT = (bf16*)(F.ws + WS_WOUT); WFO = (bf16*)(F.ws + WS_WFO); MIXED = (bf16*)(F.ws + WS_MIXED); ACT = (bf16*)(F.ws + WS_PROJ); } while (0)
#define PH_END(phidx) PH_SPIN(phidx) if ((phidx) + 1 < hi) { XcdBarrier b2 = bar; unsigned* bp_ = b2.bar; unsigned bxx_ = b2.x; asm volatile("" : "+s"(bp_), "+s"(bxx_)); b2.bar = bp_; b2.x = bxx_; xcd_barrier(b2, F.tid); } }
#define GEMM_BF16(Aop, Bop, Oop, Mm, Nn, Kk) do { pg8::Gemm g{Aop, Bop, Mm, Nn, Kk, Kk}; pg8::StaticOrder S; S.init(Mm, Nn, F.G, bx_); pg8::EpiBf16<0> E{Oop, Nn, nullptr, 0, 0, 1.f}; \
        pg8::gemm_phase<pg8::EpiBf16<0>, pg8::StaticOrder, true, true>(F.lds, g, S, E, F.tid); } while (0)
#define GEMM_TAIL(Aop, Bop, Kk, Ss, Ks) do { int ks_ = Ks, kk_ = Kk, ss_ = Ss; asm volatile("" : "+s"(ks_), "+s"(kk_), "+s"(ss_)); pg8::Gemm g{Aop, Bop, MPAD, D, ks_, kk_}; pg8::TailOrder S; S.init(ss_, ks_, F.G, bx_); pg8::EpiPartF32 E{(float*)(F.ws + WS_PART), ks_}; \
        pg8::gemm_phase<pg8::EpiPartF32, pg8::TailOrder, true, true>(F.lds, g, S, E, F.tid); } while (0)
#define GEMM_SWIGLU() do { pg8::Gemm g{XN, WFI, MPAD, NFF2, D, D}; pg8::StaticOrder S; S.init(MPAD, NFF2, F.G, bx_); pg8::EpiSwiGLU E{ACT, DFF}; \
        pg8::gemm_phase<pg8::EpiSwiGLU, pg8::StaticOrder, true, true>(F.lds, g, S, E, F.tid); } while (0)
#ifndef PROBE_DUP
#define PROBE_DUP 0
#endif
#define DUPBAR() do { XcdBarrier b2 = bar; unsigned* bp_ = b2.bar; unsigned bxx_ = b2.x; asm volatile("" : "+s"(bp_), "+s"(bxx_)); b2.bar = bp_; b2.x = bxx_; xcd_barrier(b2, F.tid); } while (0)
#define PH_RUN(l, k, code) PH_BEGIN(1 + 9 * (l) + (k)) code; if ((PROBE_DUP >> (k)) & 1) { DUPBAR(); code; } PH_END(1 + 9 * (l) + (k))
#define LAYER(l) \
    PH_RUN(l, 0, GEMM_BF16(XN, WIN, PROJ, MPAD, NPROJ, D)) \
    PH_RUN(l, 1, phase_m1(F, (l))) \
    PH_RUN(l, 2, phase_m2(F, (l))) \
    PH_RUN(l, 3, phase_m3(F, (l))) \
    PH_RUN(l, 4, GEMM_BF16(MIXED, WOUT, MOUT, R_SAMPLE, D, D); RELAUNDER(); GEMM_TAIL(MIXED, WOUT, D, TAIL_S2, TAIL_K2)) \
    PH_RUN(l, 5, phase_norm<1>(F, (l))) \
    PH_RUN(l, 6, GEMM_SWIGLU()) \
    PH_RUN(l, 7, GEMM_BF16(ACT, WFO, MOUT, R_SAMPLE, D, DFF); RELAUNDER(); GEMM_TAIL(ACT, WFO, DFF, TAIL_S4, TAIL_K4)) \
    PH_RUN(l, 8, phase_norm<2>(F, (l)))
    PH_BEGIN(0) convert_weight(F, 0, 0, F.vcu * NWAVES + F.wave, F.G * NWAVES); phase_norm<0>(F, 0); PH_END(0)
    LAYER(0)
    LAYER(1)
}

#ifndef MK_ONE_LAUNCH
#define MK_ONE_LAUNCH 1
#endif
extern "C" void kernel_launch(void* const* d_in, const int* in_sizes, int n_in, void* d_out, int out_size, void* d_ws, size_t ws_size, hipStream_t stream) {
    static int grid = 0;
    if (grid == 0) {
        if (n_in != N_IN || (size_t)out_size != O_END || ws_size < WS_END) { fprintf(stderr, "kernel_launch: unexpected shapes: n_in %d out %d ws %zu (need %zu)\n", n_in, out_size, ws_size, (size_t)WS_END); grid = -1; return; }
        int dev = 0, cus = 0, per_cu = 0;
        if (hipGetDevice(&dev) != hipSuccess || hipDeviceGetAttribute(&cus, hipDeviceAttributeMultiprocessorCount, dev) != hipSuccess) { grid = -1; return; }
        if (hipFuncSetAttribute((const void*)hybrid_fwd, hipFuncAttributeMaxDynamicSharedMemorySize, LDS_BYTES) != hipSuccess) { fprintf(stderr, "kernel_launch: hipFuncSetAttribute failed\n"); grid = -1; return; }
        if (hipOccupancyMaxActiveBlocksPerMultiprocessor(&per_cu, (const void*)hybrid_fwd, NTHREADS, LDS_BYTES) != hipSuccess || per_cu < 1) fprintf(stderr, "kernel_launch: occupancy query says %d\n", per_cu);
        (void)hipGetLastError();
        grid = cus;
        if (grid != 256) { fprintf(stderr, "kernel_launch: built for a 256-CU device, got %d\n", cus); grid = -1; return; }
    }
    if (grid < 0) return;
    (void)hipMemsetAsync((char*)d_ws + WS_CTL, 0, CTL_ZERO_BYTES, stream);
    Args a{};
    for (int i = 0; i < N_IN; ++i) a.in[i] = (const float*)d_in[i];
    a.out = (float*)d_out; a.ws = (unsigned char*)d_ws;
#if MK_ONE_LAUNCH
    a.ph_lo = 0; a.ph_hi = N_PHASES;
    hipLaunchKernelGGL(hybrid_fwd, dim3(grid), dim3(NTHREADS), LDS_BYTES, stream, a);
#else
    for (int ph = 0; ph < N_PHASES; ++ph) { a.ph_lo = ph; a.ph_hi = ph + 1; hipLaunchKernelGGL(hybrid_fwd, dim3(grid), dim3(NTHREADS), LDS_BYTES, stream, a); }
#endif
}
```
